# Optimizing an MI355X kernel written in HIP

```python
import jax, jax.numpy as jnp
from jax import lax
import numpy as np

D_MODEL = 1024
BATCH = 8
SEQ = 2048
DEPTH = 2

CHUNK = 64
HEAD_DIM = 128
MIX_WIDTH = D_MODEL
RET_WIDTH = MIX_WIDTH // 2
SB_WIDTH = MIX_WIDTH - RET_WIDTH
N_RET_HEADS = RET_WIDTH // HEAD_DIM
N_SB_HEADS = SB_WIDTH // HEAD_DIM
D_FF = ((8 * D_MODEL // 3 + 255) // 256) * 256
SB_BLOCK = 128
ROPE_BASE = 10000.0
EPS = 1e-6
IN_WIDTHS = (RET_WIDTH, RET_WIDTH, RET_WIDTH, RET_WIDTH, SB_WIDTH, SB_WIDTH, SB_WIDTH)
IN_WIDTH = sum(IN_WIDTHS)
IN_SPLITS = tuple(int(c) for c in np.cumsum(IN_WIDTHS)[:-1])

kernel_name = "hymba_retention_stickbreaking_trunk"


def rms_norm(x, g):
    xf = x.astype(jnp.float32)
    y = xf * lax.rsqrt(jnp.mean(xf * xf, axis=-1, keepdims=True) + EPS)
    return (y * g.astype(jnp.float32)).astype(x.dtype)


def to_heads(t, n_heads):
    b, s, _ = t.shape
    return t.reshape(b, s, n_heads, HEAD_DIM).transpose(0, 2, 1, 3)


def from_heads(t):
    b, h, s, d = t.shape
    return t.transpose(0, 2, 1, 3).reshape(b, s, h * d)


def head_group_norm(x, g):
    h, d = x.shape[1], x.shape[3]
    xf = x.astype(jnp.float32)
    mu = jnp.mean(xf, axis=-1, keepdims=True)
    var = jnp.mean(jnp.square(xf - mu), axis=-1, keepdims=True)
    y = (xf - mu) * lax.rsqrt(var + EPS) * g.astype(jnp.float32).reshape(h, 1, d)
    return y.astype(x.dtype)


def head_rms_norm(x, g):
    h, d = x.shape[1], x.shape[3]
    xf = x.astype(jnp.float32)
    y = xf * lax.rsqrt(jnp.mean(xf * xf, axis=-1, keepdims=True) + EPS)
    return (y * g.astype(jnp.float32).reshape(h, 1, d)).astype(x.dtype)


def apply_rotary(x):
    s, d = x.shape[2], x.shape[3]
    inv_freq = 1.0 / (ROPE_BASE ** (jnp.arange(0, d, 2, dtype=jnp.float32) / d))
    ang = jnp.arange(s, dtype=jnp.float32)[:, None] * inv_freq[None, :]
    cos = jnp.cos(ang).astype(x.dtype)
    sin = jnp.sin(ang).astype(x.dtype)
    x1, x2 = x[..., : d // 2], x[..., d // 2:]
    return jnp.concatenate([x1 * cos - x2 * sin, x1 * sin + x2 * cos], axis=-1)


def chunk_retention(q, k, v):
    b, h, s, d = q.shape
    c = CHUNK
    n = s // c
    dt = q.dtype
    log_g = jnp.log1p(-jnp.exp2(-5.0 - jnp.arange(h, dtype=jnp.float32)))
    i = jnp.arange(c, dtype=jnp.float32)
    intra_decay = jnp.exp(log_g[:, None, None] * jnp.abs(i[:, None] - i[None, :])).astype(dt)
    q_decay = jnp.exp(log_g[:, None] * (i + 1.0)).astype(dt)[..., None]
    k_decay = jnp.exp(log_g[:, None] * (c - 1.0 - i)).astype(dt)[..., None]
    chunk_decay = jnp.exp(log_g * c).astype(dt)[None, :, None, None]
    k = k * (d ** -0.5)
    qc = q.reshape(b, h, n, c, d)
    kc = k.reshape(b, h, n, c, d)
    vc = v.reshape(b, h, n, c, v.shape[-1])
    scores = jnp.einsum('bhnid,bhnjd->bhnij', qc, kc) * intra_decay[:, None]
    intra = jnp.einsum('bhnij,bhnje->bhnie', scores, vc)

    def step(state, inp):
        q_n, k_n, v_n = inp
        cross = jnp.einsum('bhid,bhde->bhie', q_n * q_decay, state)
        state = state * chunk_decay + jnp.einsum('bhjd,bhje->bhde', k_n * k_decay, v_n)
        return state, cross

    init = jnp.zeros((b, h, d, v.shape[-1]), dtype=intra.dtype)
    xs = (jnp.moveaxis(qc, 2, 0), jnp.moveaxis(kc, 2, 0), jnp.moveaxis(vc, 2, 0))
    _, cross = lax.scan(step, init, xs)
    out = intra + jnp.moveaxis(cross, 0, 2)
    return out.reshape(b, h, s, v.shape[-1])


def stick_breaking(q, k, v):
    s, d = q.shape[2], q.shape[3]
    scale = d ** -0.5
    outs = []
    for start in range(0, s, SB_BLOCK):
        end = start + SB_BLOCK
        qb = q[:, :, start:end]
        kb = k[:, :, :end]
        vb = v[:, :, :end]
        z = jnp.einsum('bhtd,bhsd->bhts', qb, kb).astype(jnp.float32) * scale
        t_pos = jnp.arange(start, end)[:, None]
        s_pos = jnp.arange(end)[None, :]
        valid = s_pos < t_pos
        log_keep = jnp.where(valid, jax.nn.log_sigmoid(-z), 0.0)
        later = lax.cumsum(log_keep, axis=3, reverse=True) - log_keep
        w = jnp.where(valid, jnp.exp(jax.nn.log_sigmoid(z) + later), 0.0)
        outs.append(jnp.einsum('bhts,bhse->bhte', w.astype(v.dtype), vb))
    return jnp.concatenate(outs, axis=2)


def setup_inputs(seed: int = 0) -> dict:
    key = jax.random.key(seed)
    ks = jax.random.split(key, 12)
    f32 = jnp.float32

    def gain(k, shape):
        return (1.0 + 0.02 * jax.random.normal(k, shape, f32)).astype(f32)

    return {
        "x": jax.random.normal(ks[0], (BATCH, SEQ, D_MODEL), f32),
        "norm1_g": gain(ks[1], (DEPTH, D_MODEL)),
        "w_in": jax.random.normal(ks[2], (DEPTH, D_MODEL, IN_WIDTH), f32) * D_MODEL ** -0.5,
        "ret_norm_g": gain(ks[3], (DEPTH, RET_WIDTH)),
        "sb_norm_g": gain(ks[4], (DEPTH, SB_WIDTH)),
        "w_out": jax.random.normal(ks[5], (DEPTH, MIX_WIDTH, D_MODEL), f32) * MIX_WIDTH ** -0.5,
        "norm2_g": gain(ks[6], (DEPTH, D_MODEL)),
        "w_gate": jax.random.normal(ks[7], (DEPTH, D_MODEL, D_FF), f32) * D_MODEL ** -0.5,
        "w_up": jax.random.normal(ks[8], (DEPTH, D_MODEL, D_FF), f32) * D_MODEL ** -0.5,
        "w_down": jax.random.normal(ks[9], (DEPTH, D_FF, D_MODEL), f32) * D_FF ** -0.5,
        "final_g": gain(ks[10], (D_MODEL,)),
    }


def reference(x, norm1_g, w_in, ret_norm_g, sb_norm_g, w_out, norm2_g, w_gate, w_up, w_down, final_g):
    for l in range(DEPTH):
        h = rms_norm(x, norm1_g[l])
        proj = h @ w_in[l]
        rq, rk, rv, rg, sq, sk, sv = jnp.split(proj, IN_SPLITS, axis=-1)
        ret = chunk_retention(apply_rotary(to_heads(rq, N_RET_HEADS)),
                              apply_rotary(to_heads(rk, N_RET_HEADS)),
                              to_heads(rv, N_RET_HEADS))
        ret = from_heads(head_group_norm(ret, ret_norm_g[l])) * jax.nn.silu(rg)
        sb = stick_breaking(to_heads(sq, N_SB_HEADS), to_heads(sk, N_SB_HEADS), to_heads(sv, N_SB_HEADS))
        sb = from_heads(head_rms_norm(sb, sb_norm_g[l]))
        x = x + jnp.concatenate([ret, sb], axis=-1) @ w_out[l]
        h = rms_norm(x, norm2_g[l])
        x = x + (jax.nn.silu(h @ w_gate[l]) * (h @ w_up[l])) @ w_down[l]
    return rms_norm(x, final_g)
```

```cpp
#include <hip/hip_runtime.h>
#include <hip/hip_cooperative_groups.h>
#include <cstdio>
#include <cstdint>
#include <cmath>
namespace cg = cooperative_groups;
namespace pg8 {
#define PG8_LAS __attribute__((address_space(3)))
typedef unsigned short bf16_t;
typedef short bf16x8 __attribute__((ext_vector_type(8)));
typedef float f32x4 __attribute__((ext_vector_type(4)));
typedef unsigned u32x4 __attribute__((ext_vector_type(4)));
constexpr int BM = 256, BK = 64, HALF = 128, HTB = HALF * BK * 2  , STAGE_BYTES = 8 * HTB, NXCD = 8, WGM = 8;

__host__ __device__ __forceinline__ int lds_byte(int r, int c) { const int st = (r >> 4) * 2 + (c >> 5), rr = r & 15, cc = c & 31, ob = rr * 64 + cc * 2; return st * 1024 + (ob ^ (((ob >> 9) & 1) << 5)); }
__host__ __device__ __forceinline__ void stage_rc(int b, int& R, int& C) { const int st = b / 1024, sb = b % 1024, swz = sb ^ (((sb >> 9) & 1) << 5); R = (st >> 1) * 16 + swz / 64; C = (st & 1) * 32 + (swz % 64) / 2; }
__host__ __device__ __forceinline__ int perm32(int rho) { const int n = rho >> 4, i = rho & 15; return 8 * (i >> 2) + 4 * n + (i & 3); }

struct Unit { int pm, pn; };
struct Gemm { const bf16_t* A; const bf16_t* Bt; int M, N, K; };

struct StaticOrder {
    int nM, nN, nwg, G, c;
    __host__ __device__ void init(int M, int N, int G_, int c_) { nM = M / BM; nN = N / BM; nwg = nM * nN; G = G_; c = c_; }
    __host__ __device__ bool next(int i, Unit& u) const {
        const long L = (long)i * G + c; if (L >= nwg) return false;
        int wgid = (int)L; { const int q = nwg / NXCD, r = nwg % NXCD, xcd = wgid % NXCD, off = wgid / NXCD; wgid = (xcd < r ? xcd * (q + 1) : r * (q + 1) + (xcd - r) * q) + off; }
        const int nig = WGM * nN, gid = wgid / nig, fm = gid * WGM, gsz = (nM - fm) < WGM ? (nM - fm) : WGM;
        u.pm = fm + ((wgid % nig) % gsz); u.pn = (wgid % nig) / gsz; return true;
    }
    __device__ __forceinline__ void a_ready(const Unit&) const {}
    __device__ __forceinline__ void done(const Unit&) const {}
};

__device__ __forceinline__ unsigned cvt_pk_bf16(float lo, float hi) { unsigned r; asm volatile("v_cvt_pk_bf16_f32 %0, %1, %2" : "=v"(r) : "v"(lo), "v"(hi)); return r; }
typedef float f32x2 __attribute__((ext_vector_type(2)));
constexpr float RMS_EPS = 1e-6f;
struct EpiA {
    static constexpr bool PERM = true, AFTER_DRAIN = false;
    bf16_t* O; const float* rowss; const float* cs; const float* sn;
    __device__ __forceinline__ void operator()(const f32x4 (&acc)[2][2][4][2], const Unit& u, int wr, int wc, int fr, int fq) const {
        const int row0 = u.pm * BM + wr * 64 + fr, colt = u.pn * BM + wc * 32 + 8 * fq, i0 = 16 * wc + 4 * fq;
        const bool rot = u.pn < 4;
        float rs[8];
#pragma unroll
        for (int i = 0; i < 8; ++i) rs[i] = rowss[row0 + (i >> 2) * HALF + (i & 3) * 16];
#pragma unroll
        for (int ai = 0; ai < 2; ++ai)
#pragma unroll
            for (int mp = 0; mp < 2; ++mp) {
                f32x4 c4[2], s4[2];
#pragma unroll
                for (int q = 0; q < 2; ++q) { c4[q] = (f32x4){1.f, 1.f, 1.f, 1.f}; s4[q] = (f32x4){0.f, 0.f, 0.f, 0.f};
                    if (rot) { const int pos = (row0 + ai * HALF + (2 * mp + q) * 16) & 2047; c4[q] = *(const f32x4*)(cs + pos * 64 + i0); s4[q] = *(const f32x4*)(sn + pos * 64 + i0); } }
#pragma unroll
                for (int q = 0; q < 2; ++q) { const int m = 2 * mp + q, row = row0 + ai * HALF + m * 16;
                    const float rstd = 1.0f / sqrtf(rs[ai * 4 + m] * (1.0f / 1024.0f) + RMS_EPS);
                    bf16_t* rowp = O + (size_t)row * 2560 + colt;
#pragma unroll
                    for (int bj = 0; bj < 2; ++bj) {
                        const f32x4 v0 = acc[ai][bj][m][0] * rstd, v1 = acc[ai][bj][m][1] * rstd;
                        f32x4 o0, o1;
                        o0[0] = v0[0] * c4[q][0] - v0[1] * s4[q][0]; o0[1] = v0[0] * s4[q][0] + v0[1] * c4[q][0];
                        o0[2] = v0[2] * c4[q][1] - v0[3] * s4[q][1]; o0[3] = v0[2] * s4[q][1] + v0[3] * c4[q][1];
                        o1[0] = v1[0] * c4[q][2] - v1[1] * s4[q][2]; o1[1] = v1[0] * s4[q][2] + v1[1] * c4[q][2];
                        o1[2] = v1[2] * c4[q][3] - v1[3] * s4[q][3]; o1[3] = v1[2] * s4[q][3] + v1[3] * c4[q][3];
                        u32x4 w; w.x = cvt_pk_bf16(o0[0], o0[1]); w.y = cvt_pk_bf16(o0[2], o0[3]); w.z = cvt_pk_bf16(o1[0], o1[1]); w.w = cvt_pk_bf16(o1[2], o1[3]);
                        *(u32x4*)(rowp + bj * HALF) = w;
                    } }
                asm volatile("" ::: "memory");
            }
    }
};
struct EpiVT {
    static constexpr bool PERM = true, AFTER_DRAIN = false;
    bf16_t* O; const float* rowss;
    __device__ __forceinline__ void operator()(const f32x4 (&acc)[2][2][4][2], const Unit& u, int wr, int wc, int fr, int fq) const {
        const int row0 = u.pm * BM + wr * 64 + fr, col0 = u.pn * BM + wc * 32 + 8 * fq;
        f32x4 r0[2], r1[2];
#pragma unroll
        for (int bj = 0; bj < 2; ++bj) {
            const f32x4 a = *(const f32x4*)(rowss + col0 + bj * HALF), b = *(const f32x4*)(rowss + col0 + bj * HALF + 4);
#pragma unroll
            for (int j = 0; j < 4; ++j) { r0[bj][j] = 1.0f / sqrtf(a[j] * (1.0f / 1024.0f) + RMS_EPS); r1[bj][j] = 1.0f / sqrtf(b[j] * (1.0f / 1024.0f) + RMS_EPS); }
        }
#pragma unroll
        for (int ai = 0; ai < 2; ++ai)
#pragma unroll
            for (int m = 0; m < 4; ++m) {
                bf16_t* rowp = O + (size_t)(row0 + ai * HALF + m * 16) * 16384 + col0;
#pragma unroll
                for (int bj = 0; bj < 2; ++bj) {
                    const f32x4 v0 = acc[ai][bj][m][0] * r0[bj], v1 = acc[ai][bj][m][1] * r1[bj];
                    u32x4 w; w.x = cvt_pk_bf16(v0[0], v0[1]); w.y = cvt_pk_bf16(v0[2], v0[3]); w.z = cvt_pk_bf16(v1[0], v1[1]); w.w = cvt_pk_bf16(v1[2], v1[3]);
                    *(u32x4*)(rowp + bj * HALF) = w;
                }
                asm volatile("" ::: "memory");
            }
    }
};
template <bool BASE_F32> struct EpiResid {
    static constexpr bool PERM = false, AFTER_DRAIN = false;
    const float* basef; bf16_t* xb; float* rowss_out;
    __device__ __forceinline__ void operator()(const f32x4 (&acc)[2][2][4][2], const Unit& u, int wr, int wc, int fr, int fq) const {
        const int col0 = u.pn * BM + wc * 32 + 4 * fq;
        typedef unsigned u32x2v __attribute__((ext_vector_type(2)));
#pragma unroll
        for (int ai = 0; ai < 2; ++ai)
#pragma unroll
            for (int mp = 0; mp < 2; ++mp) {
                f32x4 b[2][2][2];
#pragma unroll
                for (int q = 0; q < 2; ++q) { const int row = u.pm * BM + ai * HALF + wr * 64 + (2 * mp + q) * 16 + fr; const size_t off = (size_t)row * 1024 + col0;
#pragma unroll
                    for (int bj = 0; bj < 2; ++bj)
#pragma unroll
                        for (int n = 0; n < 2; ++n) {
                            if (BASE_F32) b[q][bj][n] = *(const f32x4*)(basef + off + bj * HALF + n * 16);
                            else { const u32x2v w = *(const u32x2v*)(xb + off + bj * HALF + n * 16);
                                   b[q][bj][n] = (f32x4){__uint_as_float(w.x << 16), __uint_as_float(w.x & 0xffff0000u), __uint_as_float(w.y << 16), __uint_as_float(w.y & 0xffff0000u)}; } } }
#pragma unroll
                for (int q = 0; q < 2; ++q) { const int m = 2 * mp + q; const int row = u.pm * BM + ai * HALF + wr * 64 + m * 16 + fr; const size_t off = (size_t)row * 1024 + col0; float ss = 0.f;
#pragma unroll
                    for (int bj = 0; bj < 2; ++bj)
#pragma unroll
                        for (int n = 0; n < 2; ++n) {
                            const f32x4 o = b[q][bj][n] + acc[ai][bj][m][n];
                            ss += (o[0] * o[0] + o[1] * o[1]) + (o[2] * o[2] + o[3] * o[3]);
                            u32x2v w; w.x = cvt_pk_bf16(o[0], o[1]); w.y = cvt_pk_bf16(o[2], o[3]); *(u32x2v*)(xb + off + bj * HALF + n * 16) = w;
                        }
                    ss += __shfl_xor(ss, 16); ss += __shfl_xor(ss, 32);
                    if (fq == 0) atomicAdd(rowss_out + row, ss); }
                asm volatile("" ::: "memory");
            }
    }
};
struct EpiSwiGLU {
    static constexpr bool PERM = true, AFTER_DRAIN = false;
    bf16_t* O; const float* rowss;
    __device__ __forceinline__ void operator()(const f32x4 (&acc)[2][2][4][2], const Unit& u, int wr, int wc, int fr, int fq) const {
        const int row0 = u.pm * BM + wr * 64 + fr, col0 = u.pn * HALF + wc * 32 + 8 * fq;
        float rs[8];
#pragma unroll
        for (int i = 0; i < 8; ++i) rs[i] = rowss[row0 + (i >> 2) * HALF + (i & 3) * 16];
#pragma unroll
        for (int ai = 0; ai < 2; ++ai)
#pragma unroll
            for (int m = 0; m < 4; ++m) {
                const int row = row0 + ai * HALF + m * 16;
                const float rstd = 1.0f / sqrtf(rs[ai * 4 + m] * (1.0f / 1024.0f) + RMS_EPS);
                float r[8];
#pragma unroll
                for (int n = 0; n < 2; ++n)
#pragma unroll
                    for (int j = 0; j < 4; ++j) { const float g = acc[ai][0][m][n][j] * rstd, up = acc[ai][1][m][n][j] * rstd; r[n * 4 + j] = g * up * __builtin_amdgcn_rcpf(1.0f + __expf(-g)); }
                u32x4 w; w.x = cvt_pk_bf16(r[0], r[1]); w.y = cvt_pk_bf16(r[2], r[3]); w.z = cvt_pk_bf16(r[4], r[5]); w.w = cvt_pk_bf16(r[6], r[7]);
                *(u32x4*)(O + (size_t)row * 2816 + col0) = w;
            }
    }
};
template <class Epi, class Sched, bool ALIGN_EPI = false, bool SP2 = false>
__device__ __forceinline__ void gemm_phase(PG8_LAS unsigned char* lds, const Gemm g, const Sched& S, const Epi& E, const int tid) {
    const int wid = __builtin_amdgcn_readfirstlane(tid >> 6), lane = tid & 63, wr = wid >> 2, wc = wid & 3, fr = lane & 15, fq = lane >> 4;
    const int K = g.K, nt = K / BK;
    unsigned voffA[2], voffB[2];
#pragma unroll
    for (int i = 0; i < 2; ++i) { int R, C; stage_rc(tid * 16 + i * 8192, R, C); const int Rb = Epi::PERM ? ((R & ~31) + perm32(R & 31)) : R;
        voffA[i] = (unsigned)(R * K + C) * 2u; voffB[i] = (unsigned)(Rb * K + C) * 2u; }
    const size_t kstep = (size_t)(BK * 2);
    const size_t hstep = (size_t)HALF * K * 2;
    const size_t tstep = 2 * hstep;
    const unsigned ldsw = (unsigned)wid * 1024u;
    const int aoff = lds_byte(wr * 64 + fr, fq * 8), boff = lds_byte(wc * 32 + fr, fq * 8);
#define PG8_SA(b, h) (((b) * 2 + (h)) * HTB)
#define PG8_SB(b, h) ((4 + (b) * 2 + (h)) * HTB)
#define PG8_STAGE(bufoff, gbase, voff) do { _Pragma("unroll") for (int _i = 0; _i < 2; ++_i) \
        __builtin_amdgcn_global_load_lds((const unsigned*)((const char*)(gbase) + (voff)[_i]), (PG8_LAS unsigned*)(lds + (bufoff) + ldsw + _i * 8192), 16, 0, 0); } while (0)
#define PG8_LDA(dst, b, h) do { _Pragma("unroll") for (int m = 0; m < 4; ++m) _Pragma("unroll") for (int k = 0; k < 2; ++k) dst[m][k] = *(const PG8_LAS bf16x8*)(lds + PG8_SA(b, h) + aoff + m * 2048 + k * 1024); } while (0)
#define PG8_LDB(dst, b, h) do { _Pragma("unroll") for (int n = 0; n < 2; ++n) _Pragma("unroll") for (int k = 0; k < 2; ++k) dst[n][k] = *(const PG8_LAS bf16x8*)(lds + PG8_SB(b, h) + boff + n * 2048 + k * 1024); } while (0)
#define PG8_MMA(ai, bj, At, Bt) do { __builtin_amdgcn_s_setprio(1); _Pragma("unroll") for (int m = 0; m < 4; ++m) _Pragma("unroll") for (int n = 0; n < 2; ++n) _Pragma("unroll") for (int k = 0; k < 2; ++k) \
        acc[ai][bj][m][n] = __builtin_amdgcn_mfma_f32_16x16x32_bf16(Bt[n][k], At[m][k], acc[ai][bj][m][n], 0, 0, 0); __builtin_amdgcn_s_setprio(0); } while (0)
#define PG8_WAIT_V(n) asm volatile("s_waitcnt vmcnt(" #n ")" ::: "memory")
#define PG8_WAIT_L(n) asm volatile("s_waitcnt lgkmcnt(" #n ")" ::: "memory")
#define PG8_BAR __builtin_amdgcn_s_barrier()
#define PG8_SCHED __builtin_amdgcn_sched_barrier(0)
    Unit cur, nxt; int ui = 0;
    if (!S.next(0, cur)) return;
    f32x4 acc[2][2][4][2];
#pragma unroll
    for (int a = 0; a < 2; ++a)
#pragma unroll
        for (int b = 0; b < 2; ++b)
#pragma unroll
            for (int m = 0; m < 4; ++m)
#pragma unroll
                for (int n = 0; n < 2; ++n) acc[a][b][m][n] = (f32x4){0.f, 0.f, 0.f, 0.f};
    bf16x8 At[4][2], B0[2][2], B1[2][2];
    const char* cA = (const char*)g.A + (size_t)cur.pm * tstep; const char* cB = (const char*)g.Bt + (size_t)cur.pn * tstep;
    S.a_ready(cur);
    if constexpr (SP2) {
        PG8_STAGE(PG8_SB(0, 0), cB, voffB); PG8_STAGE(PG8_SB(0, 1), cB + hstep, voffB); PG8_STAGE(PG8_SA(0, 0), cA, voffA); PG8_STAGE(PG8_SA(0, 1), cA + hstep, voffA);
        if (wr == 1) PG8_BAR;
        PG8_WAIT_V(2); PG8_BAR;
        PG8_STAGE(PG8_SB(1, 0), cB + kstep, voffB); PG8_STAGE(PG8_SA(1, 0), cA + kstep, voffA); PG8_STAGE(PG8_SB(1, 1), cB + hstep + kstep, voffB);
        PG8_WAIT_V(6); PG8_BAR;
    } else {
        PG8_STAGE(PG8_SB(0, 0), cB, voffB); PG8_STAGE(PG8_SA(0, 0), cA, voffA); PG8_STAGE(PG8_SB(0, 1), cB + hstep, voffB); PG8_STAGE(PG8_SA(0, 1), cA + hstep, voffA);
        if (wr == 1) PG8_BAR;
        PG8_WAIT_V(4); PG8_BAR;
        PG8_STAGE(PG8_SB(1, 0), cB + kstep, voffB); PG8_STAGE(PG8_SA(1, 0), cA + kstep, voffA); PG8_STAGE(PG8_SB(1, 1), cB + hstep + kstep, voffB);
        PG8_WAIT_V(6); PG8_BAR;
    }
    for (;;) {
        const bool has_next = S.next(ui + 1, nxt);
        const char* nA = has_next ? (const char*)g.A + (size_t)nxt.pm * tstep : cA; const char* nB = has_next ? (const char*)g.Bt + (size_t)nxt.pn * tstep : cB;
        for (int t = 0; t < nt; t += 2) {
            const bool last = (t == nt - 2);
            const char* a1 = cA + (size_t)(t + 1) * kstep;
            const char* a2 = last ? nA : cA + (size_t)(t + 2) * kstep; const char* b2 = last ? nB : cB + (size_t)(t + 2) * kstep;
            const char* a3 = a2 + kstep; const char* b3 = b2 + kstep;
            if (last && has_next) S.a_ready(nxt);
            if constexpr (SP2) {
            PG8_LDB(B0, 0, 0); PG8_LDB(B1, 0, 1); PG8_SCHED; PG8_LDA(At, 0, 0); PG8_STAGE(PG8_SA(1, 1), a1 + hstep, voffA);
            PG8_WAIT_V(8); PG8_WAIT_L(0); PG8_BAR; PG8_MMA(0, 0, At, B0); PG8_MMA(0, 1, At, B1); PG8_BAR; PG8_SCHED;
            PG8_LDA(At, 0, 1); PG8_STAGE(PG8_SB(0, 0), b2, voffB); PG8_STAGE(PG8_SB(0, 1), b2 + hstep, voffB); PG8_STAGE(PG8_SA(0, 0), a2, voffA);
            PG8_WAIT_V(8); PG8_WAIT_L(0); PG8_BAR; PG8_MMA(1, 0, At, B0); PG8_MMA(1, 1, At, B1); PG8_BAR; PG8_SCHED;
            PG8_LDB(B0, 1, 0); PG8_LDB(B1, 1, 1); PG8_SCHED; PG8_LDA(At, 1, 0); PG8_STAGE(PG8_SA(0, 1), a2 + hstep, voffA);
            PG8_WAIT_V(8); PG8_WAIT_L(0); PG8_BAR; PG8_MMA(0, 0, At, B0); PG8_MMA(0, 1, At, B1); PG8_BAR; PG8_SCHED;
            PG8_LDA(At, 1, 1); PG8_STAGE(PG8_SB(1, 0), b3, voffB); PG8_STAGE(PG8_SB(1, 1), b3 + hstep, voffB); PG8_STAGE(PG8_SA(1, 0), a3, voffA);
            PG8_WAIT_V(8); PG8_WAIT_L(0); PG8_BAR; PG8_MMA(1, 0, At, B0); PG8_MMA(1, 1, At, B1); PG8_BAR; PG8_SCHED;
            } else {
            PG8_LDB(B0, 0, 0); PG8_SCHED; PG8_LDA(At, 0, 0); PG8_STAGE(PG8_SA(1, 1), a1 + hstep, voffA);
            PG8_WAIT_L(8); PG8_BAR; PG8_WAIT_L(0); PG8_MMA(0, 0, At, B0); PG8_BAR; PG8_SCHED;
            PG8_LDB(B1, 0, 1); PG8_STAGE(PG8_SB(0, 0), b2, voffB);
            PG8_BAR; PG8_WAIT_L(0); PG8_MMA(0, 1, At, B1); PG8_BAR;
            PG8_LDA(At, 0, 1); PG8_STAGE(PG8_SA(0, 0), a2, voffA);
            PG8_BAR; PG8_WAIT_L(0); PG8_MMA(1, 0, At, B0); PG8_BAR; PG8_SCHED;
            PG8_STAGE(PG8_SB(0, 1), b2 + hstep, voffB);
            PG8_WAIT_V(6); PG8_BAR; PG8_MMA(1, 1, At, B1); PG8_BAR;
            PG8_LDB(B0, 1, 0); PG8_SCHED; PG8_LDA(At, 1, 0); PG8_STAGE(PG8_SA(0, 1), a2 + hstep, voffA);
            PG8_WAIT_L(8); PG8_BAR; PG8_WAIT_L(0); PG8_MMA(0, 0, At, B0); PG8_BAR; PG8_SCHED;
            PG8_LDB(B1, 1, 1); PG8_STAGE(PG8_SB(1, 0), b3, voffB);
            PG8_BAR; PG8_WAIT_L(0); PG8_MMA(0, 1, At, B1); PG8_BAR;
            PG8_LDA(At, 1, 1); PG8_STAGE(PG8_SA(1, 0), a3, voffA);
            PG8_BAR; PG8_WAIT_L(0); PG8_MMA(1, 0, At, B0); PG8_BAR; PG8_SCHED;
            PG8_STAGE(PG8_SB(1, 1), b3 + hstep, voffB);
            PG8_WAIT_V(6); PG8_BAR; PG8_MMA(1, 1, At, B1); PG8_BAR;
            }
        }
        if constexpr (ALIGN_EPI) { if (wr == 0) PG8_BAR; }
        if constexpr (!Epi::AFTER_DRAIN) { E(acc, cur, wr, wc, fr, fq); S.done(cur); }
        if (!has_next) break;
#pragma unroll
        for (int a = 0; a < 2; ++a)
#pragma unroll
            for (int b = 0; b < 2; ++b)
#pragma unroll
                for (int m = 0; m < 4; ++m)
#pragma unroll
                    for (int n = 0; n < 2; ++n) acc[a][b][m][n] = (f32x4){0.f, 0.f, 0.f, 0.f};
        cur = nxt; cA = nA; cB = nB; ++ui;
        if constexpr (ALIGN_EPI) { if (wr == 1) PG8_BAR; }
    }
    PG8_WAIT_V(0);
    if constexpr (!ALIGN_EPI) { if (wr == 0) PG8_BAR; }
    PG8_BAR;
    if constexpr (Epi::AFTER_DRAIN) { E.fused(acc, cur, wr, wc, fr, fq, lds, wid, lane); S.done(cur); }
#undef PG8_SA
#undef PG8_SB
#undef PG8_STAGE
#undef PG8_LDA
#undef PG8_LDB
#undef PG8_MMA
#undef PG8_WAIT_V
#undef PG8_WAIT_L
#undef PG8_BAR
#undef PG8_SCHED
}
}
#define LAS __attribute__((address_space(3)))
typedef unsigned short bf16;
typedef float f32x4 __attribute__((ext_vector_type(4)));
typedef short bf16x8 __attribute__((ext_vector_type(8)));
typedef unsigned u32x4 __attribute__((ext_vector_type(4)));
typedef unsigned u32x2 __attribute__((ext_vector_type(2)));
#ifndef MK_MULTI
#define MK_MULTI 0
#endif
constexpr int NTOK = 16384, DM = 1024, SEQ = 2048, DFF = 2816, NA = 2560, NPH = 12;
constexpr int COL_RQ = 0, COL_RK = 512, COL_RG = 1024, COL_SQ = 1536, COL_SK = 2048;
constexpr size_t MiB = 1u << 20;
constexpr size_t WS_BAR = 4096  ;
constexpr size_t WS_CNT = 0, WS_RSS = 65536  , WS_COS = 1 * MiB, WS_SIN = 1 * MiB + 512 * 1024;
constexpr size_t WS_W = 2 * MiB, W_LAYER = 25 * MiB + 512 * 1024, WO_A = 0, WO_V = 5 * MiB, WO_O = 7 * MiB, WO_GU = 9 * MiB, WO_D = 20 * MiB;
constexpr size_t WS_XB = 54 * MiB, WS_MIX = 86 * MiB, WS_PA = 118 * MiB, WS_VT = 198 * MiB, WS_ACT = 118 * MiB, WS_END = 230 * MiB;
constexpr int LDS_BYTES = 147456, LDS_Q = 131072;
constexpr int N_RET = 32 * 8  , N_SBU = 512;

typedef float f32x2_t __attribute__((ext_vector_type(2))); typedef __bf16 bf16x2_t __attribute__((ext_vector_type(2)));
__device__ __forceinline__ unsigned pkbf(float lo, float hi) { f32x2_t v = {lo, hi}; bf16x2_t b = __builtin_convertvector(v, bf16x2_t); return __builtin_bit_cast(unsigned, b); }
__device__ __forceinline__ float bf_lo(unsigned w) { return __uint_as_float(w << 16); }
__device__ __forceinline__ float bf_hi(unsigned w) { return __uint_as_float(w & 0xffff0000u); }
__device__ __forceinline__ float wave_sum(float v) {
#pragma unroll
    for (int o = 1; o < 64; o <<= 1) v += __shfl_xor(v, o);
    return v;
}
#define MFMA16(a, b, c) __builtin_amdgcn_mfma_f32_16x16x32_bf16((a), (b), (c), 0, 0, 0)

struct Args { const float* in[11]; float* out; unsigned char* ws; float inv_freq[64]; float lg2[4]; int ph_lo, ph_hi; };

__device__ __forceinline__ void tr_item(const float* __restrict__ W, int Nsrc, const float* __restrict__ g, int K, bf16* __restrict__ WT, int d0, int k0, int col, float sc, LAS float* scr, int lane) {
    float wv[32];
#pragma unroll
    for (int i = 0; i < 32; ++i) wv[i] = W[(size_t)(k0 + 2 * i + (lane >> 5)) * Nsrc + col];
#pragma unroll
    for (int i = 0; i < 32; ++i) { const int kk = 2 * i + (lane >> 5); const float gv = g ? g[k0 + kk] : 1.0f; scr[kk * 33 + (lane & 31)] = wv[i] * (gv * sc); }
    asm volatile("s_waitcnt lgkmcnt(0)" ::: "memory");
    const int c = lane & 7;
#pragma unroll
    for (int j = 0; j < 4; ++j) { const int n = (lane >> 3) + 8 * j; const LAS float* s = scr + (8 * c) * 33 + n;
        u32x4 o; o.x = pkbf(s[0 * 33], s[1 * 33]); o.y = pkbf(s[2 * 33], s[3 * 33]); o.z = pkbf(s[4 * 33], s[5 * 33]); o.w = pkbf(s[6 * 33], s[7 * 33]);
        *(u32x4*)(WT + (size_t)(d0 + n) * K + k0 + 8 * c) = o; }
    asm volatile("s_waitcnt lgkmcnt(0)" ::: "memory");
}
__device__ __forceinline__ void sincos_acc(float angf, float& s, float& c) {
    const double a = (double)angf, q = rint(a * 0.63661977236758134308), r = a - q * 1.57079632679489661923, r2 = r * r;
    const double sn = r * (1.0 + r2 * (-1.0 / 6 + r2 * (1.0 / 120 + r2 * (-1.0 / 5040 + r2 * (1.0 / 362880 + r2 * (-1.0 / 39916800))))));
    const double cs = 1.0 + r2 * (-0.5 + r2 * (1.0 / 24 + r2 * (-1.0 / 720 + r2 * (1.0 / 40320 + r2 * (-1.0 / 3628800 + r2 * (1.0 / 479001600))))));
    const int n = ((int)q) & 3;
    const double so = (n == 0) ? sn : (n == 1) ? cs : (n == 2) ? -sn : -cs;
    const double co = (n == 0) ? cs : (n == 1) ? -sn : (n == 2) ? -cs : sn;
    s = (float)so; c = (float)co;
}
constexpr int I_A = 16 * 80, I_V = 16 * 32, I_O = 16 * 32, I_GU = 16 * 176, I_D = 44 * 32, I_L = I_A + I_V + I_O + I_GU + I_D;
constexpr int CVT_EARLY = I_A + I_V;
constexpr int N_CVT = (2 * I_L - CVT_EARLY) / 8;
static_assert((I_L - CVT_EARLY) % 8 == 0 && I_L % 8 == 0, "conversion items per block");
__device__ __forceinline__ void cvt_item(const Args& a, LAS float* scr, int it, int lane) {
    unsigned char* ws = a.ws;
    const int l = it / I_L; int r = it % I_L;
    unsigned char* wl = ws + WS_W + (size_t)l * W_LAYER;
    const float* w_in = a.in[2] + (size_t)l * 1024 * 3584; const float* g1 = a.in[1] + l * 1024; const float* g2 = a.in[6] + l * 1024;
    if (r < I_A) { const int db = r % 80, kb = r / 80, dr = 32 * db + (lane & 31), sec = dr >> 9, within = dr & 511; int col; float sc = 1.0f;
        if (sec < 2) { const int h = within >> 7, p = within & 127; col = sec * 512 + h * 128 + (p >> 1) + 64 * (p & 1); if (sec == 1) sc = 0.08838834764831845f; }
        else if (sec == 2) col = 1536 + within;
        else if (sec == 3) { col = 2048 + within; sc = 0.08838834764831845f * 1.4426950408889634f; }
        else col = 2560 + within;
        tr_item(w_in, 3584, g1, 1024, (bf16*)(wl + WO_A), 32 * db, 64 * kb, col, sc, scr, lane); return; } r -= I_A;
    if (r < I_V) { const int db = r % 32, kb = r / 32, dr = 32 * db + (lane & 31); const int col = dr < 512 ? 1024 + dr : 3072 + (dr - 512);
        tr_item(w_in, 3584, g1, 1024, (bf16*)(wl + WO_V), 32 * db, 64 * kb, col, 1.0f, scr, lane); return; } r -= I_V;
    if (r < I_O) { const int db = r % 32, kb = r / 32;
        tr_item(a.in[5] + (size_t)l * 1024 * 1024, 1024, nullptr, 1024, (bf16*)(wl + WO_O), 32 * db, 64 * kb, 32 * db + (lane & 31), 1.0f, scr, lane); return; } r -= I_O;
    if (r < I_GU) { const int db = r % 176, kb = r / 176, d0 = 32 * db, pn = d0 >> 8, j0 = d0 & 255; const bool up = j0 >= 128;
        const float* W = (up ? a.in[8] : a.in[7]) + (size_t)l * 1024 * DFF; const int col = 128 * pn + (j0 & 127) + (lane & 31);
        tr_item(W, DFF, g2, 1024, (bf16*)(wl + WO_GU), d0, 64 * kb, col, 1.0f, scr, lane); return; } r -= I_GU;
    { const int db = r % 32, kb = r / 32;
        tr_item(a.in[9] + (size_t)l * DFF * 1024, 1024, nullptr, DFF, (bf16*)(wl + WO_D), 32 * db, 64 * kb, 32 * db + (lane & 31), 1.0f, scr, lane); }
}
__device__ __forceinline__ void prologue(const Args& a, LAS unsigned char* lds, int G, int tid, int wave, int lane) {
    unsigned char* ws = a.ws;
    const int gw = blockIdx.x * 8 + wave, NGW = G * 8, gt = blockIdx.x * 512 + tid, NGT = G * 512;
    for (int i = gt; i < 4 * NTOK; i += NGT) ((float*)(ws + WS_RSS))[NTOK + i] = 0.f;
    LAS float* ifr = (LAS float*)(lds + LDS_Q + 64);
    if (tid == 0) {
#pragma unroll
        for (int i = 0; i < 64; ++i) ifr[i] = a.inv_freq[i];
    }
    __syncthreads();
    for (int i = gt; i < SEQ * 64; i += NGT) { const int pos = i >> 6, k = i & 63; float s, c; sincos_acc((float)pos * ifr[k], s, c); ((float*)(ws + WS_COS))[i] = c; ((float*)(ws + WS_SIN))[i] = s; }
    LAS float* scr = (LAS float*)(lds + wave * 16384);
    for (int it = gw; it < CVT_EARLY; it += NGW) cvt_item(a, scr, it, lane);
    const float* x = a.in[0]; bf16* xb = (bf16*)(ws + WS_XB); float* rss0 = (float*)(ws + WS_RSS);
    for (int m = gw; m < NTOK; m += 2 * NGW) {
        const int m2 = m + NGW;
        const f32x4* xr = (const f32x4*)(x + (size_t)m * DM) + lane; const f32x4* xr2 = (const f32x4*)(x + (size_t)m2 * DM) + lane; f32x4 v[4], v2[4]; float s = 0.f, s2 = 0.f;
#pragma unroll
        for (int j = 0; j < 4; ++j) { v[j] = xr[64 * j]; v2[j] = xr2[64 * j]; }
#pragma unroll
        for (int j = 0; j < 4; ++j) { s += (v[j][0] * v[j][0] + v[j][1] * v[j][1]) + (v[j][2] * v[j][2] + v[j][3] * v[j][3]); s2 += (v2[j][0] * v2[j][0] + v2[j][1] * v2[j][1]) + (v2[j][2] * v2[j][2] + v2[j][3] * v2[j][3]); }
        s = wave_sum(s); s2 = wave_sum(s2); if (lane == 0) { rss0[m] = s; rss0[m2] = s2; }
        u32x2* o8 = (u32x2*)(xb + (size_t)m * DM) + lane; u32x2* o82 = (u32x2*)(xb + (size_t)m2 * DM) + lane;
#pragma unroll
        for (int j = 0; j < 4; ++j) { u32x2 w; w.x = pkbf(v[j][0], v[j][1]); w.y = pkbf(v[j][2], v[j][3]); o8[64 * j] = w; u32x2 w2; w2.x = pkbf(v2[j][0], v2[j][1]); w2.y = pkbf(v2[j][2], v2[j][3]); o82[64 * j] = w2; }
    }
}
__device__ __forceinline__ void final_norm(const Args& a, int G, int wave, int lane) {
    const int gw = blockIdx.x * 8 + wave, NGW = G * 8; const float* rss = (const float*)(a.ws + WS_RSS) + 4 * NTOK; const float* fg = a.in[10]; const bf16* xb = (const bf16*)(a.ws + WS_XB);
    f32x4 gv[4];
#pragma unroll
    for (int j = 0; j < 4; ++j) gv[j] = ((const f32x4*)fg)[lane + 64 * j];
    for (int m = gw; m < NTOK; m += NGW) {
        const float rstd = 1.0f / sqrtf(rss[m] * (1.0f / 1024.0f) + 1e-6f);
        const u32x2* xr = (const u32x2*)(xb + (size_t)m * DM) + lane; f32x4* orow = (f32x4*)(a.out + (size_t)m * DM) + lane;
#pragma unroll
        for (int j = 0; j < 4; ++j) { const u32x2 w = xr[64 * j]; const f32x4 v = (f32x4){bf_lo(w.x), bf_hi(w.x), bf_lo(w.y), bf_hi(w.y)}; orow[64 * j] = v * rstd * gv[j]; }
    }
}
#define XB_TMO      128
#define XB_XCNT(j)  (256  + 64 * (j))
#define XB_XSUB(j)  (1280 + 64 * (j))
#define XB_XGEN(j)  (2304 + 64 * (j))
#define XB_TOP      3328
#define XB_TOPGEN   3392
#define XCD_BAR_WORDS 3456
#define XB_SPIN_CAP (1u << 18)

__device__ __forceinline__ unsigned xb_ld(unsigned* p)              { return __hip_atomic_load(p, __ATOMIC_RELAXED, __HIP_MEMORY_SCOPE_AGENT); }
__device__ __forceinline__ unsigned xb_add(unsigned* p, unsigned v) { return __hip_atomic_fetch_add(p, v, __ATOMIC_RELAXED, __HIP_MEMORY_SCOPE_AGENT); }
__device__ __forceinline__ unsigned xb_xcc_id() { return (unsigned)__builtin_amdgcn_s_getreg((3 << 11) | 20) & 0xFu; }
#define XB_SPIN(cond, bar) do { unsigned _sp = 0; while (cond) { __builtin_amdgcn_s_sleep(1); \
    if ((++_sp & 255u) == 0u) { if (xb_ld(&(bar)[XB_TMO])) break; if (_sp > XB_SPIN_CAP) { atomicAdd(&(bar)[XB_TMO], 1u); break; } } } } while (0)

struct XcdBarrier {
    unsigned* bar; unsigned x;
    volatile LAS unsigned* st;
};

__device__ __forceinline__ XcdBarrier xcd_barrier_post(unsigned* bar, volatile LAS unsigned* st) {
    XcdBarrier b; b.bar = bar; b.x = xb_xcc_id(); b.st = st;
    if (threadIdx.x == 0) (void)xb_add(&bar[XB_XCNT(b.x)], 1u);
    return b;
}
__device__ __forceinline__ void xcd_barrier_complete(unsigned* bar, unsigned x, unsigned& nloc, unsigned& nx) {
    const unsigned G = gridDim.x * gridDim.y * gridDim.z;
    unsigned sum, cnt, mine, sp = 0u;
    for (;;) {
        sum = 0u; cnt = 0u; mine = 0u;
#pragma unroll
        for (unsigned j = 0; j < 16; ++j) { const unsigned c = xb_ld(&bar[XB_XCNT(j)]); sum += c; cnt += (c > 0u) ? 1u : 0u; mine = (j == x) ? c : mine; }
        if (sum == G) break;
        __builtin_amdgcn_s_sleep(1);
        if ((++sp & 255u) == 0u) { if (xb_ld(&bar[XB_TMO])) break; if (sp > XB_SPIN_CAP) { atomicAdd(&bar[XB_TMO], 1u); break; } }
    }
    nloc = mine > 0u ? mine : 1u; nx = cnt > 0u ? cnt : 1u;
}

__device__ __forceinline__ void xcd_barrier(const XcdBarrier& b) {
    asm volatile("s_waitcnt vmcnt(0)" ::: "memory");
    __syncthreads();
    if (threadIdx.x == 0) {
        unsigned* bar = b.bar;
        __builtin_amdgcn_s_waitcnt(0);
        unsigned nloc = b.st[0], nx = b.st[1];
        if (nloc == 0u) { xcd_barrier_complete(bar, b.x, nloc, nx); b.st[0] = nloc; b.st[1] = nx; }
        const unsigned old = xb_add(&bar[XB_XSUB(b.x)], 1u);
        const unsigned gen = old / nloc;
        if (old + 1u == (gen + 1u) * nloc) {
            __builtin_amdgcn_fence(__ATOMIC_RELEASE, "agent");
            asm volatile("s_waitcnt vmcnt(0)" ::: "memory");
            const unsigned og = xb_add(&bar[XB_TOP], 1u);
            const unsigned tg = og / nx;
            if (og + 1u == (tg + 1u) * nx) xb_add(&bar[XB_TOPGEN], 1u);
            else XB_SPIN(xb_ld(&bar[XB_TOPGEN]) == tg, bar);
            __builtin_amdgcn_fence(__ATOMIC_ACQUIRE, "agent");
            xb_add(&bar[XB_XGEN(b.x)], 1u);
            asm volatile("s_waitcnt vmcnt(0)" ::: "memory");
        } else {
            XB_SPIN(xb_ld(&bar[XB_XGEN(b.x)]) == gen, bar);
            __builtin_amdgcn_fence(__ATOMIC_ACQUIRE, "agent");
            asm volatile("s_waitcnt vmcnt(0)" ::: "memory");
        }
    }
    __syncthreads();
}
constexpr int RET_P = 8, RET_CPP = 32 / RET_P;
constexpr int R_QS = 0, R_KS = 17408, R_KT = 34816, R_VT = 53248, R_SD = 71680, R_ST = 80896, R_OF = 0;
__device__ __forceinline__ void ret_item(LAS unsigned char* lds, const bf16* __restrict__ PA, const bf16* __restrict__ VT, bf16* __restrict__ MIX, const float* __restrict__ gret, float lg2, int b, int h, int part_p, int tid, int wid, int lane) {
    const int fr = lane & 15, fq = lane >> 4;
    f32x4 st[8];
#pragma unroll
    for (int i = 0; i < 8; ++i) st[i] = (f32x4){0.f, 0.f, 0.f, 0.f};
    for (int i = tid; i < 34816 / 16; i += 512) *(LAS u32x4*)(lds + R_ST + i * 16) = (u32x4){0u, 0u, 0u, 0u};
    const float cd = __builtin_amdgcn_exp2f(lg2 * 64.0f);
    const bf16* qg = PA + (size_t)(b * SEQ) * NA + COL_RQ + h * 128;
    const bf16* kg = PA + (size_t)(b * SEQ) * NA + COL_RK + h * 128;
    const bf16* gg = PA + (size_t)(b * SEQ) * NA + COL_RG + h * 128;
    const bf16* vg = VT + (size_t)(h * 128) * NTOK + b * SEQ;
    u32x4 qr[2], kr[2], vr[2], gr[2];
    const int nfull0 = RET_CPP * part_p, nend = nfull0 + RET_CPP;
#define LOAD_KV(KR, VR, n) do { _Pragma("unroll") for (int i = 0; i < 2; ++i) { const int pi = tid + 512 * i; \
        KR[i] = *(const u32x4*)(kg + (size_t)(64 * (n) + (pi >> 4)) * NA + 8 * (pi & 15)); VR[i] = *(const u32x4*)(vg + (size_t)(pi >> 3) * NTOK + 64 * (n) + 8 * (pi & 7)); } } while (0)
#define RET_LOAD(n) do { LOAD_KV(kr, vr, n); _Pragma("unroll") for (int i = 0; i < 2; ++i) { const int pi = tid + 512 * i; qr[i] = *(const u32x4*)(qg + (size_t)(64 * (n) + (pi >> 4)) * NA + 8 * (pi & 15)); } } while (0)
#define STAGE_KV(KR, VR) do { _Pragma("unroll") for (int i = 0; i < 2; ++i) { const int pi = tid + 512 * i, row = pi >> 4, c8 = pi & 15; \
            const float kd = __builtin_amdgcn_exp2f(lg2 * (float)(63 - row)); const int sw = R_KT + (((row >> 3) ^ (c8 & 7)) << 4) + (row & 7) * 2; \
            _Pragma("unroll") for (int j = 0; j < 4; ++j) { const unsigned w = KR[i][j]; const unsigned p = pkbf(bf_lo(w) * kd, bf_hi(w) * kd); \
                *(LAS unsigned short*)(lds + sw + (8 * c8 + 2 * j) * 144) = (unsigned short)(p & 0xffffu); *(LAS unsigned short*)(lds + sw + (8 * c8 + 2 * j + 1) * 144) = (unsigned short)(p >> 16); } \
            *(LAS u32x4*)(lds + R_VT + (pi >> 3) * 144 + (pi & 7) * 16) = VR[i]; } } while (0)
#define STEP4(VA, WRITE_ST) do { _Pragma("unroll") for (int dt = 0; dt < 8; ++dt) { st[dt] = st[dt] * cd; \
            _Pragma("unroll") for (int ks = 0; ks < 2; ++ks) { const int d = 16 * dt + fr; const bf16x8 kb = *(const LAS bf16x8*)(lds + R_KT + d * 144 + (((4 * ks + fq) ^ ((d >> 3) & 7)) << 4)); st[dt] = MFMA16(VA[ks], kb, st[dt]); } \
            if (WRITE_ST) { _Pragma("unroll") for (int r = 0; r < 4; ++r) { const unsigned p = pkbf(st[dt][r], 0.f); *(LAS unsigned short*)(lds + R_ST + (16 * wid + 4 * fq + r) * 272 + (16 * dt + fr) * 2) = (unsigned short)(p & 0xffffu); } } \
            asm volatile("" ::: "memory"); } } while (0)
#define LOAD_VA(VA) do { _Pragma("unroll") for (int ks = 0; ks < 2; ++ks) VA[ks] = *(const LAS bf16x8*)(lds + R_VT + (16 * wid + fr) * 144 + (32 * ks + 8 * fq) * 2); } while (0)
    if (nfull0 > 0) {
        LOAD_KV(kr, vr, 0); LOAD_KV(qr, gr, 1);
        for (int n = 0; n < nfull0; n += 2) {
            __syncthreads(); STAGE_KV(kr, vr); __syncthreads();
            if (n + 2 < nfull0) LOAD_KV(kr, vr, n + 2);
            { bf16x8 vp[2]; LOAD_VA(vp); STEP4(vp, false); }
            __syncthreads(); STAGE_KV(qr, gr); __syncthreads();
            const bool lastp = (n + 2 >= nfull0);
            if (!lastp) LOAD_KV(qr, gr, n + 3); else RET_LOAD(nfull0);
            { bf16x8 vp[2]; LOAD_VA(vp); STEP4(vp, lastp); }
        }
    } else RET_LOAD(0);
    for (int n = nfull0; n < nend; ++n) {
        __syncthreads();
#pragma unroll
        for (int i = 0; i < 2; ++i) { const int pi = tid + 512 * i, row = pi >> 4, c8 = pi & 15;
            *(LAS u32x4*)(lds + R_QS + row * 272 + c8 * 16) = qr[i]; *(LAS u32x4*)(lds + R_KS + row * 272 + c8 * 16) = kr[i]; }
        STAGE_KV(kr, vr);
        __syncthreads();
        if (n + 1 < nend) RET_LOAD(n + 1);
        gr[0] = *(const u32x4*)(gg + (size_t)(64 * n + (tid >> 3)) * NA + 16 * (tid & 7)); gr[1] = *(const u32x4*)(gg + (size_t)(64 * n + (tid >> 3)) * NA + 16 * (tid & 7) + 8);
#pragma unroll
        for (int q = 0; q < 2; ++q) { const int idx = 2 * wid + q, stile = idx >> 2, ttile = idx & 3; f32x4 acc = (f32x4){0.f, 0.f, 0.f, 0.f};
#pragma unroll
            for (int ks = 0; ks < 4; ++ks) { const bf16x8 ka = *(const LAS bf16x8*)(lds + R_KS + (16 * stile + fr) * 272 + (32 * ks + 8 * fq) * 2), qb = *(const LAS bf16x8*)(lds + R_QS + (16 * ttile + fr) * 272 + (32 * ks + 8 * fq) * 2);
                acc = MFMA16(ka, qb, acc); }
            const int t = 16 * ttile + fr, s0 = 16 * stile + 4 * fq; float v[4];
#pragma unroll
            for (int r = 0; r < 4; ++r) { const int d = t - (s0 + r); v[r] = acc[r] * __builtin_amdgcn_exp2f(lg2 * (float)(d < 0 ? -d : d)); }
            u32x2 w; w.x = pkbf(v[0], v[1]); w.y = pkbf(v[2], v[3]); *(LAS u32x2*)(lds + R_SD + t * 144 + s0 * 2) = w; }
        f32x4 cacc[4], iacc[4];
#pragma unroll
        for (int tt = 0; tt < 4; ++tt) { cacc[tt] = (f32x4){0.f, 0.f, 0.f, 0.f}; iacc[tt] = (f32x4){0.f, 0.f, 0.f, 0.f}; }
#pragma unroll
        for (int ks = 0; ks < 4; ++ks) { const bf16x8 sa = *(const LAS bf16x8*)(lds + R_ST + (16 * wid + fr) * 272 + (32 * ks + 8 * fq) * 2);
#pragma unroll
            for (int tt = 0; tt < 4; ++tt) { const bf16x8 qb = *(const LAS bf16x8*)(lds + R_QS + (16 * tt + fr) * 272 + (32 * ks + 8 * fq) * 2); cacc[tt] = MFMA16(sa, qb, cacc[tt]); } asm volatile("" ::: "memory"); }
        __syncthreads();
        bf16x8 va[2];
#pragma unroll
        for (int ks = 0; ks < 2; ++ks) { va[ks] = *(const LAS bf16x8*)(lds + R_VT + (16 * wid + fr) * 144 + (32 * ks + 8 * fq) * 2);
#pragma unroll
            for (int tt = 0; tt < 4; ++tt) { const bf16x8 sb = *(const LAS bf16x8*)(lds + R_SD + (16 * tt + fr) * 144 + (32 * ks + 8 * fq) * 2); iacc[tt] = MFMA16(va[ks], sb, iacc[tt]); } }
        STEP4(va, true);
#pragma unroll
        for (int tt = 0; tt < 4; ++tt) { const int t = 16 * tt + fr; const float qd = __builtin_amdgcn_exp2f(lg2 * (float)(t + 1));
            const f32x4 o = iacc[tt] + cacc[tt] * qd; *(LAS f32x4*)(lds + R_OF + t * 528 + (16 * wid + 4 * fq) * 4) = o; }
        __syncthreads();
        { const int t = tid >> 3, part = tid & 7; const size_t row = (size_t)(b * SEQ + 64 * n + t); f32x4 x[4]; float s = 0.f;
#pragma unroll
            for (int j = 0; j < 4; ++j) { x[j] = *(const LAS f32x4*)(lds + R_OF + t * 528 + (16 * part + 4 * j) * 4); s += (x[j][0] + x[j][1]) + (x[j][2] + x[j][3]); }
            s += __shfl_xor(s, 1); s += __shfl_xor(s, 2); s += __shfl_xor(s, 4);
            const float mu = s * (1.0f / 128.0f); float q = 0.f;
#pragma unroll
            for (int j = 0; j < 4; ++j) { x[j] = x[j] - mu; q += (x[j][0] * x[j][0] + x[j][1] * x[j][1]) + (x[j][2] * x[j][2] + x[j][3] * x[j][3]); }
            q += __shfl_xor(q, 1); q += __shfl_xor(q, 2); q += __shfl_xor(q, 4);
            const float rstd = 1.0f / sqrtf(q * (1.0f / 128.0f) + 1e-6f);
            const u32x4 g0 = gr[0], g1 = gr[1];
            float y[16];
#pragma unroll
            for (int j = 0; j < 4; ++j) { const f32x4 gn = *(const f32x4*)(gret + h * 128 + 16 * part + 4 * j);
#pragma unroll
                for (int c = 0; c < 4; ++c) { const unsigned gw = (j < 2 ? g0 : g1)[(2 * j + (c >> 1)) & 3]; const float gt = (c & 1) ? bf_hi(gw) : bf_lo(gw);
                    y[4 * j + c] = x[j][c] * rstd * gn[c] * (gt * __builtin_amdgcn_rcpf(1.0f + __expf(-gt))); } }
            u32x4 o0, o1; o0.x = pkbf(y[0], y[1]); o0.y = pkbf(y[2], y[3]); o0.z = pkbf(y[4], y[5]); o0.w = pkbf(y[6], y[7]); o1.x = pkbf(y[8], y[9]); o1.y = pkbf(y[10], y[11]); o1.z = pkbf(y[12], y[13]); o1.w = pkbf(y[14], y[15]);
            *(u32x4*)(MIX + row * DM + h * 128 + 16 * part) = o0; *(u32x4*)(MIX + row * DM + h * 128 + 16 * part + 8) = o1; }
    }
#undef RET_LOAD
#undef LOAD_KV
#undef STAGE_KV
#undef STEP4
#undef LOAD_VA
}
constexpr int S_KS = 0, S_VT = 17408;
__device__ __forceinline__ void sb_unit(LAS unsigned char* lds, const bf16* __restrict__ PA, const bf16* __restrict__ VT, bf16* __restrict__ MIX, const float* __restrict__ gsb, int b, int h, int qb, int tid, int wid, int lane) {
    const int fr = lane & 15, fq = lane >> 4, t0 = qb * 128 + wid * 16, tq = t0 + fr;
    const size_t rowq = (size_t)(b * SEQ + tq);
    bf16x8 qf[4];
#pragma unroll
    for (int ks = 0; ks < 4; ++ks) qf[ks] = *(const bf16x8*)(PA + rowq * NA + COL_SQ + h * 128 + 32 * ks + 8 * fq);
    f32x4 o[8];
#pragma unroll
    for (int i = 0; i < 8; ++i) o[i] = (f32x4){0.f, 0.f, 0.f, 0.f};
    float carry = 0.f;
    const bf16* kg = PA + (size_t)(b * SEQ) * NA + COL_SK + h * 128;
    const bf16* vg = VT + (size_t)(512 + h * 128) * NTOK + b * SEQ;
    u32x4 kr[2], vr[2];
#define SB_LOAD(kb) do { _Pragma("unroll") for (int i = 0; i < 2; ++i) { const int pi = tid + 512 * i; \
        kr[i] = *(const u32x4*)(kg + (size_t)(64 * (kb) + (pi >> 4)) * NA + 8 * (pi & 15)); vr[i] = *(const u32x4*)(vg + (size_t)(pi >> 3) * NTOK + 64 * (kb) + 8 * (pi & 7)); } } while (0)
    const int nkb = 2 * qb + 2;
    SB_LOAD(nkb - 1);
    volatile LAS unsigned* sflag = (volatile LAS unsigned*)(lds + LDS_Q + 1024);
    if (lane == 0) sflag[wid] = 0u;
    for (int kb = nkb - 1; kb >= 0; --kb) {
        __syncthreads();
        { unsigned all = 1u;
#pragma unroll
          for (int w8 = 0; w8 < 8; ++w8) all &= sflag[w8];
          if (__builtin_amdgcn_readfirstlane(all)) break; }
#pragma unroll
        for (int i = 0; i < 2; ++i) { const int pi = tid + 512 * i; *(LAS u32x4*)(lds + S_KS + (pi >> 4) * 272 + (pi & 15) * 16) = kr[i]; *(LAS u32x4*)(lds + S_VT + (pi >> 3) * 144 + (pi & 7) * 16) = vr[i]; }
        __syncthreads();
        if (kb > 0) SB_LOAD(kb - 1);
        if (64 * kb < t0 + 15) {
            f32x4 s[4];
#pragma unroll
            for (int kt = 0; kt < 4; ++kt) { s[kt] = (f32x4){0.f, 0.f, 0.f, 0.f}; const int krow = 32 * (kt >> 1) + 8 * (fr >> 2) + 4 * (kt & 1) + (fr & 3);
#pragma unroll
                for (int ks = 0; ks < 4; ++ks) { const bf16x8 ka = *(const LAS bf16x8*)(lds + S_KS + krow * 272 + (32 * ks + 8 * fq) * 2); s[kt] = MFMA16(ka, qf[ks], s[kt]); } }
            bf16x8 wf[2];
#pragma unroll
            for (int p = 1; p >= 0; --p) {
                const int key0 = 64 * kb + 32 * p + 8 * fq; float m[8], lk[8], ex[8];
#pragma unroll
                for (int j = 0; j < 8; ++j) { const float z = s[2 * p + (j >> 2)][j & 3]; const float e = __builtin_amdgcn_exp2f(-fabsf(z)); const float lg = __builtin_amdgcn_logf(1.0f + e);
                    m[j] = fminf(z, 0.f) - lg; lk[j] = (key0 + j < tq) ? (m[j] - z) : 0.f; }
                ex[7] = 0.f;
#pragma unroll
                for (int j = 6; j >= 0; --j) ex[j] = ex[j + 1] + lk[j + 1];
                const float G = ex[0] + lk[0], G1 = __shfl_xor(G, 16), G2 = __shfl_xor(G, 32), G3 = __shfl_xor(G, 48);
                const float off = (((fq ^ 1) > fq) ? G1 : 0.f) + (((fq ^ 2) > fq) ? G2 : 0.f) + (((fq ^ 3) > fq) ? G3 : 0.f);
                const float base = carry + off; float w[8];
#pragma unroll
                for (int j = 0; j < 8; ++j) w[j] = (key0 + j < tq) ? __builtin_amdgcn_exp2f(m[j] + base + ex[j]) : 0.f;
                carry += (G + G1) + (G2 + G3);
                u32x4 pw; pw.x = pkbf(w[0], w[1]); pw.y = pkbf(w[2], w[3]); pw.z = pkbf(w[4], w[5]); pw.w = pkbf(w[6], w[7]);
                wf[p] = __builtin_bit_cast(bf16x8, pw);
            }
#pragma unroll
            for (int et = 0; et < 8; ++et)
#pragma unroll
                for (int p = 0; p < 2; ++p) { const bf16x8 va = *(const LAS bf16x8*)(lds + S_VT + (16 * et + fr) * 144 + (32 * p + 8 * fq) * 2); o[et] = MFMA16(va, wf[p], o[et]); }
            const bool dn = __all(carry < -150.0f);
            if (lane == 0) sflag[wid] = dn ? 1u : 0u;
        }
    }
#undef SB_LOAD
    float ss = 0.f;
#pragma unroll
    for (int et = 0; et < 8; ++et) ss += (o[et][0] * o[et][0] + o[et][1] * o[et][1]) + (o[et][2] * o[et][2] + o[et][3] * o[et][3]);
    ss += __shfl_xor(ss, 16); ss += __shfl_xor(ss, 32);
    const float rstd = 1.0f / sqrtf(ss * (1.0f / 128.0f) + 1e-6f);
#pragma unroll
    for (int et = 0; et < 8; ++et) { const f32x4 gn = *(const f32x4*)(gsb + h * 128 + 16 * et + 4 * fq); const f32x4 y = o[et] * rstd * gn;
        u32x2 w; w.x = pkbf(y[0], y[1]); w.y = pkbf(y[2], y[3]); *(u32x2*)(MIX + rowq * DM + 512 + h * 128 + 16 * et + 4 * fq) = w; }
}
__device__ __forceinline__ int lane_now() { int x; asm volatile("v_mbcnt_lo_u32_b32 %0, -1, 0\n\tv_mbcnt_hi_u32_b32 %0, -1, %0" : "=v"(x)); return x; }
__global__ void __launch_bounds__(512, 2) hymba_fwd(Args a) {
    extern __shared__ __attribute__((aligned(16))) unsigned char lds_raw[];
    LAS unsigned char* lds = (LAS unsigned char*)lds_raw;
    const int wave_s = __builtin_amdgcn_readfirstlane((int)threadIdx.x >> 6), G = gridDim.x;
#define tid (wave_s * 64 + lane_now())
    unsigned char* ws = a.ws;
    volatile LAS unsigned* xst = (volatile LAS unsigned*)(lds + LDS_Q + 512);
    if (tid < 2) xst[tid] = 0u;
    __syncthreads();
#if !MK_MULTI
    XcdBarrier xbar = xcd_barrier_post((unsigned*)(ws + WS_BAR), xst);
#endif
    const int lo = a.ph_lo, hi = a.ph_hi;
#define OPAQUE_TID() int tp = tid; asm volatile("" : "+v"(tp)); const int lp = tp & 63, wp = __builtin_amdgcn_readfirstlane(tp >> 6); (void)lp; (void)wp
#define IN(k) (lo <= (k) && (k) < hi)
#if MK_MULTI
#define SEAM(k) do { } while (0)
#else
#define SEAM(k) do { if (IN(k) && IN((k) + 1)) { xcd_barrier(xbar); } } while (0)
#endif
    bf16* xb = (bf16*)(ws + WS_XB); bf16* mix = (bf16*)(ws + WS_MIX); bf16* pa = (bf16*)(ws + WS_PA); bf16* vt = (bf16*)(ws + WS_VT); bf16* act = (bf16*)(ws + WS_ACT);
    float* rss = (float*)(ws + WS_RSS); const float* cst = (const float*)(ws + WS_COS); const float* snt = (const float*)(ws + WS_SIN);
#ifndef NO_PRO
#if !MK_MULTI
    if (a.ph_hi < 0) cg::this_grid().sync();
#endif
    if (IN(0)) { OPAQUE_TID(); prologue(a, lds, G, tp, wp, lp); }
#endif
    SEAM(0);
    for (int l = 0; l < 2; ++l) {
        const unsigned char* wl = ws + WS_W + (size_t)l * W_LAYER; const int p0 = 1 + 5 * l;
#ifndef NO_A
        if (IN(p0)) {
            { OPAQUE_TID(); pg8::Gemm g{xb, (const bf16*)(wl + WO_A), NTOK, NA, DM}; pg8::StaticOrder S; S.init(NTOK, NA, G, (int)blockIdx.x);
              pg8::EpiA E{pa, rss + (2 * l) * NTOK, cst, snt}; pg8::gemm_phase<pg8::EpiA, pg8::StaticOrder, true, true>(lds, g, S, E, tp); }
            { OPAQUE_TID(); pg8::Gemm g{(const bf16*)(wl + WO_V), xb, 1024, NTOK, DM}; pg8::StaticOrder S; S.init(1024, NTOK, G, (int)blockIdx.x);
              pg8::EpiVT E{vt, rss + (2 * l) * NTOK}; pg8::gemm_phase<pg8::EpiVT, pg8::StaticOrder, true, true>(lds, g, S, E, tp); }
            if (l == 0 && G == 256 && blockIdx.x >= 128) {
                OPAQUE_TID();
                for (int j = (int)blockIdx.x - 128; j < (I_L - CVT_EARLY) / 8; j += 128) cvt_item(a, (LAS float*)(lds + wp * 16384), CVT_EARLY + j * 8 + wp, lp);
            } else if (l == 0 && G != 256) { OPAQUE_TID(); for (int j = (int)blockIdx.x; j < (I_L - CVT_EARLY) / 8; j += G) cvt_item(a, (LAS float*)(lds + wp * 16384), CVT_EARLY + j * 8 + wp, lp); }
        }
#endif
        SEAM(p0);
#ifndef NO_B
        if (IN(p0 + 1)) {
            OPAQUE_TID(); unsigned* cnt = (unsigned*)(ws + WS_CNT) + l; LAS int* qs = (LAS int*)(lds + LDS_Q);
            const float* gret = a.in[3] + l * 512; const float* gsb = a.in[4] + l * 512;
            for (;;) {
                __syncthreads();
                if (tp == 0) *qs = (int)atomicAdd(cnt, 1u);
                __syncthreads();
                const int item = __builtin_amdgcn_readfirstlane(*qs);
                int ti = tp; asm volatile("" : "+v"(ti)); const int li = ti & 63, wi = __builtin_amdgcn_readfirstlane(ti >> 6);
                if (item >= N_RET + N_SBU) break;
#ifdef NO_RET
                if (item < N_RET) {}
#else
                if (item < N_RET) { const int bh = item & 31, pp = RET_P - 1 - (item >> 5); ret_item(lds, pa, vt, mix, gret, ((bh & 3) == 0 ? a.lg2[0] : (bh & 3) == 1 ? a.lg2[1] : (bh & 3) == 2 ? a.lg2[2] : a.lg2[3]), bh >> 2, bh & 3, pp, ti, wi, li); }
#endif
#ifdef NO_SBU
                else {}
#else
                else { const int idx = item - N_RET, qb = 15 - (idx >> 5), bh = idx & 31; sb_unit(lds, pa, vt, mix, gsb, bh >> 2, bh & 3, qb, ti, wi, li); }
#endif
            }
        }
#endif
        SEAM(p0 + 1);
#ifndef NO_C
        if (IN(p0 + 2)) {
            OPAQUE_TID(); pg8::Gemm g{mix, (const bf16*)(wl + WO_O), NTOK, DM, DM}; pg8::StaticOrder S; S.init(NTOK, DM, G, (int)blockIdx.x);
            if (l == 0) { pg8::EpiResid<true> E{a.in[0], xb, rss + (2 * l + 1) * NTOK}; pg8::gemm_phase<pg8::EpiResid<true>, pg8::StaticOrder, true, true>(lds, g, S, E, tp); }
            else { pg8::EpiResid<false> E{nullptr, xb, rss + (2 * l + 1) * NTOK}; pg8::gemm_phase<pg8::EpiResid<false>, pg8::StaticOrder, true, true>(lds, g, S, E, tp); }
        }
#endif
        SEAM(p0 + 2);
#ifndef NO_D
        if (IN(p0 + 3)) {
            OPAQUE_TID(); pg8::Gemm g{xb, (const bf16*)(wl + WO_GU), NTOK, 2 * DFF, DM}; pg8::StaticOrder S; S.init(NTOK, 2 * DFF, G, (int)blockIdx.x);
            pg8::EpiSwiGLU E{act, rss + (2 * l + 1) * NTOK}; pg8::gemm_phase<pg8::EpiSwiGLU, pg8::StaticOrder, true, true>(lds, g, S, E, tp);
            if (l == 0 && G == 256 && blockIdx.x >= 128) {
                int t3 = tid; asm volatile("" : "+v"(t3)); const int l3 = t3 & 63, w3 = __builtin_amdgcn_readfirstlane(t3 >> 6);
                for (int j = (int)blockIdx.x - 128; j < I_L / 8; j += 128) cvt_item(a, (LAS float*)(lds + w3 * 16384), I_L + j * 8 + w3, l3);
            } else if (l == 0 && G != 256) { int t3 = tid; asm volatile("" : "+v"(t3)); const int l3 = t3 & 63, w3 = __builtin_amdgcn_readfirstlane(t3 >> 6); for (int j = (int)blockIdx.x; j < I_L / 8; j += G) cvt_item(a, (LAS float*)(lds + w3 * 16384), I_L + j * 8 + w3, l3); }
        }
#endif
        SEAM(p0 + 3);
#ifndef NO_E
        if (IN(p0 + 4)) {
            OPAQUE_TID(); pg8::Gemm g{act, (const bf16*)(wl + WO_D), NTOK, DM, DFF}; pg8::StaticOrder S; S.init(NTOK, DM, G, (int)blockIdx.x);
            pg8::EpiResid<false> E{nullptr, xb, rss + (2 * l + 2) * NTOK}; pg8::gemm_phase<pg8::EpiResid<false>, pg8::StaticOrder, true, true>(lds, g, S, E, tp);
        }
#endif
        SEAM(p0 + 4);
    }
    if (IN(11)) { OPAQUE_TID(); final_norm(a, G, wp, lp); }
#undef IN
#undef SEAM
#undef tid
}
extern "C" void kernel_launch(void* const* d_in, const int* in_sizes, int n_in, void* d_out, int out_size, void* d_ws, size_t ws_size, hipStream_t stream) {
    static int grid = 0;
    if (grid == 0) {
        if (n_in != 11 || in_sizes[0] != NTOK * DM || out_size != NTOK * DM || ws_size < WS_END) { fprintf(stderr, "kernel_launch: unexpected shapes (n_in %d, ws %zu)\n", n_in, ws_size); grid = -1; return; }
        int dev = 0, cus = 0, per_cu = 0;
        if (hipGetDevice(&dev) != hipSuccess || hipDeviceGetAttribute(&cus, hipDeviceAttributeMultiprocessorCount, dev) != hipSuccess) { grid = -1; return; }
        if (hipFuncSetAttribute((const void*)hymba_fwd, hipFuncAttributeMaxDynamicSharedMemorySize, LDS_BYTES) != hipSuccess) { fprintf(stderr, "kernel_launch: hipFuncSetAttribute failed\n"); grid = -1; return; }
        if (hipOccupancyMaxActiveBlocksPerMultiprocessor(&per_cu, (const void*)hymba_fwd, 512, LDS_BYTES) != hipSuccess || per_cu < 1) { fprintf(stderr, "kernel_launch: occupancy query says %d\n", per_cu); per_cu = 1; }
        (void)hipGetLastError();
        grid = cus;
        if (grid > 256) grid = 256;
    }
    if (grid < 0) return;
    (void)hipMemsetAsync(d_ws, 0, 65536, stream);
    Args a{};
    for (int i = 0; i < 11; ++i) a.in[i] = (const float*)d_in[i];
    a.out = (float*)d_out; a.ws = (unsigned char*)d_ws;
    for (int i = 0; i < 64; ++i) a.inv_freq[i] = 1.0f / powf(10000.0f, (float)(2 * i) / 128.0f);
    for (int h = 0; h < 4; ++h) a.lg2[h] = (float)(log1p(-exp2(-5.0 - (double)h)) / log(2.0));
#if MK_MULTI
    for (int p = 0; p < NPH; ++p) { a.ph_lo = p; a.ph_hi = p + 1; hipLaunchKernelGGL(hymba_fwd, dim3(grid), dim3(512), LDS_BYTES, stream, a); }
#else
    a.ph_lo = 0; a.ph_hi = NPH;
    void* args[] = {&a};
    hipError_t e = hipLaunchCooperativeKernel((const void*)hymba_fwd, dim3(grid), dim3(512), args, LDS_BYTES, stream);
    if (e != hipSuccess) fprintf(stderr, "cooperative launch failed: %s (grid %d)\n", hipGetErrorString(e), grid);
#endif
}
```

```cpp
#include <hip/hip_runtime.h>
#include <hip/hip_cooperative_groups.h>
#include <cstdio>
#include <cstdint>
#include <cmath>
namespace cg = cooperative_groups;
namespace pg8 {
#define PG8_LAS __attribute__((address_space(3)))
typedef unsigned short bf16_t;
typedef short bf16x8 __attribute__((ext_vector_type(8)));
typedef float f32x4 __attribute__((ext_vector_type(4)));
typedef unsigned u32x4 __attribute__((ext_vector_type(4)));
constexpr int BM = 256, BK = 64, HALF = 128, HTB = HALF * BK * 2  , STAGE_BYTES = 8 * HTB, NXCD = 8, WGM = 8;

__host__ __device__ __forceinline__ int lds_byte(int r, int c) { const int st = (r >> 4) * 2 + (c >> 5), rr = r & 15, cc = c & 31, ob = rr * 64 + cc * 2; return st * 1024 + (ob ^ (((ob >> 9) & 1) << 5)); }
__host__ __device__ __forceinline__ void stage_rc(int b, int& R, int& C) { const int st = b / 1024, sb = b % 1024, swz = sb ^ (((sb >> 9) & 1) << 5); R = (st >> 1) * 16 + swz / 64; C = (st & 1) * 32 + (swz % 64) / 2; }
__host__ __device__ __forceinline__ int perm32(int rho) { const int n = rho >> 4, i = rho & 15; return 8 * (i >> 2) + 4 * n + (i & 3); }

struct Unit { int pm, pn; };
struct Gemm { const bf16_t* A; const bf16_t* Bt; int M, N, K; };

struct StaticOrder {
    int nM, nN, nwg, G, c;
    __host__ __device__ void init(int M, int N, int G_, int c_) { nM = M / BM; nN = N / BM; nwg = nM * nN; G = G_; c = c_; }
    __host__ __device__ bool next(int i, Unit& u) const {
        const long L = (long)i * G + c; if (L >= nwg) return false;
        int wgid = (int)L; { const int q = nwg / NXCD, r = nwg % NXCD, xcd = wgid % NXCD, off = wgid / NXCD; wgid = (xcd < r ? xcd * (q + 1) : r * (q + 1) + (xcd - r) * q) + off; }
        const int nig = WGM * nN, gid = wgid / nig, fm = gid * WGM, gsz = (nM - fm) < WGM ? (nM - fm) : WGM;
        u.pm = fm + ((wgid % nig) % gsz); u.pn = (wgid % nig) / gsz; return true;
    }
    __device__ __forceinline__ void a_ready(const Unit&) const {}
    __device__ __forceinline__ void done(const Unit&) const {}
};

__device__ __forceinline__ unsigned cvt_pk_bf16(float lo, float hi) { unsigned r; asm volatile("v_cvt_pk_bf16_f32 %0, %1, %2" : "=v"(r) : "v"(lo), "v"(hi)); return r; }
typedef float f32x2 __attribute__((ext_vector_type(2)));
constexpr float RMS_EPS = 1e-6f;
struct EpiA {
    static constexpr bool PERM = true, AFTER_DRAIN = false;
    bf16_t* O; const float* rowss; const float* cs; const float* sn;
    __device__ __forceinline__ void operator()(const f32x4 (&acc)[2][2][4][2], const Unit& u, int wr, int wc, int fr, int fq) const {
        const int row0 = u.pm * BM + wr * 64 + fr, colt = u.pn * BM + wc * 32 + 8 * fq, i0 = 16 * wc + 4 * fq;
        const bool rot = u.pn < 4;
        float rs[8];
#pragma unroll
        for (int i = 0; i < 8; ++i) rs[i] = rowss[row0 + (i >> 2) * HALF + (i & 3) * 16];
#pragma unroll
        for (int ai = 0; ai < 2; ++ai)
#pragma unroll
            for (int mp = 0; mp < 2; ++mp) {
                f32x4 c4[2], s4[2];
#pragma unroll
                for (int q = 0; q < 2; ++q) { c4[q] = (f32x4){1.f, 1.f, 1.f, 1.f}; s4[q] = (f32x4){0.f, 0.f, 0.f, 0.f};
                    if (rot) { const int pos = (row0 + ai * HALF + (2 * mp + q) * 16) & 2047; c4[q] = *(const f32x4*)(cs + pos * 64 + i0); s4[q] = *(const f32x4*)(sn + pos * 64 + i0); } }
#pragma unroll
                for (int q = 0; q < 2; ++q) { const int m = 2 * mp + q, row = row0 + ai * HALF + m * 16;
                    const float rstd = 1.0f / sqrtf(rs[ai * 4 + m] * (1.0f / 1024.0f) + RMS_EPS);
                    bf16_t* rowp = O + (size_t)row * 2560 + colt;
#pragma unroll
                    for (int bj = 0; bj < 2; ++bj) {
                        const f32x4 v0 = acc[ai][bj][m][0] * rstd, v1 = acc[ai][bj][m][1] * rstd;
                        f32x4 o0, o1;
                        o0[0] = v0[0] * c4[q][0] - v0[1] * s4[q][0]; o0[1] = v0[0] * s4[q][0] + v0[1] * c4[q][0];
                        o0[2] = v0[2] * c4[q][1] - v0[3] * s4[q][1]; o0[3] = v0[2] * s4[q][1] + v0[3] * c4[q][1];
                        o1[0] = v1[0] * c4[q][2] - v1[1] * s4[q][2]; o1[1] = v1[0] * s4[q][2] + v1[1] * c4[q][2];
                        o1[2] = v1[2] * c4[q][3] - v1[3] * s4[q][3]; o1[3] = v1[2] * s4[q][3] + v1[3] * c4[q][3];
                        u32x4 w; w.x = cvt_pk_bf16(o0[0], o0[1]); w.y = cvt_pk_bf16(o0[2], o0[3]); w.z = cvt_pk_bf16(o1[0], o1[1]); w.w = cvt_pk_bf16(o1[2], o1[3]);
                        *(u32x4*)(rowp + bj * HALF) = w;
                    } }
                asm volatile("" ::: "memory");
            }
    }
};
struct EpiVT {
    static constexpr bool PERM = true, AFTER_DRAIN = false;
    bf16_t* O; const float* rowss;
    __device__ __forceinline__ void operator()(const f32x4 (&acc)[2][2][4][2], const Unit& u, int wr, int wc, int fr, int fq) const {
        const int row0 = u.pm * BM + wr * 64 + fr, col0 = u.pn * BM + wc * 32 + 8 * fq;
        f32x4 r0[2], r1[2];
#pragma unroll
        for (int bj = 0; bj < 2; ++bj) {
            const f32x4 a = *(const f32x4*)(rowss + col0 + bj * HALF), b = *(const f32x4*)(rowss + col0 + bj * HALF + 4);
#pragma unroll
            for (int j = 0; j < 4; ++j) { r0[bj][j] = 1.0f / sqrtf(a[j] * (1.0f / 1024.0f) + RMS_EPS); r1[bj][j] = 1.0f / sqrtf(b[j] * (1.0f / 1024.0f) + RMS_EPS); }
        }
#pragma unroll
        for (int ai = 0; ai < 2; ++ai)
#pragma unroll
            for (int m = 0; m < 4; ++m) {
                bf16_t* rowp = O + (size_t)(row0 + ai * HALF + m * 16) * 16384 + col0;
#pragma unroll
                for (int bj = 0; bj < 2; ++bj) {
                    const f32x4 v0 = acc[ai][bj][m][0] * r0[bj], v1 = acc[ai][bj][m][1] * r1[bj];
                    u32x4 w; w.x = cvt_pk_bf16(v0[0], v0[1]); w.y = cvt_pk_bf16(v0[2], v0[3]); w.z = cvt_pk_bf16(v1[0], v1[1]); w.w = cvt_pk_bf16(v1[2], v1[3]);
                    *(u32x4*)(rowp + bj * HALF) = w;
                }
                asm volatile("" ::: "memory");
            }
    }
};
template <bool BASE_F32> struct EpiResid {
    static constexpr bool PERM = false, AFTER_DRAIN = false;
    const float* basef; bf16_t* xb; float* rowss_out;
    __device__ __forceinline__ void operator()(const f32x4 (&acc)[2][2][4][2], const Unit& u, int wr, int wc, int fr, int fq) const {
        const int col0 = u.pn * BM + wc * 32 + 4 * fq;
        typedef unsigned u32x2v __attribute__((ext_vector_type(2)));
#pragma unroll
        for (int ai = 0; ai < 2; ++ai)
#pragma unroll
            for (int mp = 0; mp < 2; ++mp) {
                f32x4 b[2][2][2];
#pragma unroll
                for (int q = 0; q < 2; ++q) { const int row = u.pm * BM + ai * HALF + wr * 64 + (2 * mp + q) * 16 + fr; const size_t off = (size_t)row * 1024 + col0;
#pragma unroll
                    for (int bj = 0; bj < 2; ++bj)
#pragma unroll
                        for (int n = 0; n < 2; ++n) {
                            if (BASE_F32) b[q][bj][n] = *(const f32x4*)(basef + off + bj * HALF + n * 16);
                            else { const u32x2v w = *(const u32x2v*)(xb + off + bj * HALF + n * 16);
                                   b[q][bj][n] = (f32x4){__uint_as_float(w.x << 16), __uint_as_float(w.x & 0xffff0000u), __uint_as_float(w.y << 16), __uint_as_float(w.y & 0xffff0000u)}; } } }
#pragma unroll
                for (int q = 0; q < 2; ++q) { const int m = 2 * mp + q; const int row = u.pm * BM + ai * HALF + wr * 64 + m * 16 + fr; const size_t off = (size_t)row * 1024 + col0; float ss = 0.f;
#pragma unroll
                    for (int bj = 0; bj < 2; ++bj)
#pragma unroll
                        for (int n = 0; n < 2; ++n) {
                            const f32x4 o = b[q][bj][n] + acc[ai][bj][m][n];
                            ss += (o[0] * o[0] + o[1] * o[1]) + (o[2] * o[2] + o[3] * o[3]);
                            u32x2v w; w.x = cvt_pk_bf16(o[0], o[1]); w.y = cvt_pk_bf16(o[2], o[3]); *(u32x2v*)(xb + off + bj * HALF + n * 16) = w;
                        }
                    ss += __shfl_xor(ss, 16); ss += __shfl_xor(ss, 32);
                    if (fq == 0) atomicAdd(rowss_out + row, ss); }
                asm volatile("" ::: "memory");
            }
    }
};
struct EpiSwiGLU {
    static constexpr bool PERM = true, AFTER_DRAIN = false;
    bf16_t* O; const float* rowss;
    __device__ __forceinline__ void operator()(const f32x4 (&acc)[2][2][4][2], const Unit& u, int wr, int wc, int fr, int fq) const {
        const int row0 = u.pm * BM + wr * 64 + fr, col0 = u.pn * HALF + wc * 32 + 8 * fq;
        float rs[8];
#pragma unroll
        for (int i = 0; i < 8; ++i) rs[i] = rowss[row0 + (i >> 2) * HALF + (i & 3) * 16];
#pragma unroll
        for (int ai = 0; ai < 2; ++ai)
#pragma unroll
            for (int m = 0; m < 4; ++m) {
                const int row = row0 + ai * HALF + m * 16;
                const float rstd = 1.0f / sqrtf(rs[ai * 4 + m] * (1.0f / 1024.0f) + RMS_EPS);
                float r[8];
#pragma unroll
                for (int n = 0; n < 2; ++n)
#pragma unroll
                    for (int j = 0; j < 4; ++j) { const float g = acc[ai][0][m][n][j] * rstd, up = acc[ai][1][m][n][j] * rstd; r[n * 4 + j] = g * up * __builtin_amdgcn_rcpf(1.0f + __expf(-g)); }
                u32x4 w; w.x = cvt_pk_bf16(r[0], r[1]); w.y = cvt_pk_bf16(r[2], r[3]); w.z = cvt_pk_bf16(r[4], r[5]); w.w = cvt_pk_bf16(r[6], r[7]);
                *(u32x4*)(O + (size_t)row * 2816 + col0) = w;
            }
    }
};
template <class Epi, class Sched, bool ALIGN_EPI = false, bool SP2 = false>
__device__ __forceinline__ void gemm_phase(PG8_LAS unsigned char* lds, const Gemm g, const Sched& S, const Epi& E, const int tid) {
    const int wid = __builtin_amdgcn_readfirstlane(tid >> 6), lane = tid & 63, wr = wid >> 2, wc = wid & 3, fr = lane & 15, fq = lane >> 4;
    const int K = g.K, nt = K / BK;
    unsigned voffA[2], voffB[2];
#pragma unroll
    for (int i = 0; i < 2; ++i) { int R, C; stage_rc(tid * 16 + i * 8192, R, C); const int Rb = Epi::PERM ? ((R & ~31) + perm32(R & 31)) : R;
        voffA[i] = (unsigned)(R * K + C) * 2u; voffB[i] = (unsigned)(Rb * K + C) * 2u; }
    const size_t kstep = (size_t)(BK * 2);
    const size_t hstep = (size_t)HALF * K * 2;
    const size_t tstep = 2 * hstep;
    const unsigned ldsw = (unsigned)wid * 1024u;
    const int aoff = lds_byte(wr * 64 + fr, fq * 8), boff = lds_byte(wc * 32 + fr, fq * 8);
#define PG8_SA(b, h) (((b) * 2 + (h)) * HTB)
#define PG8_SB(b, h) ((4 + (b) * 2 + (h)) * HTB)
#define PG8_STAGE(bufoff, gbase, voff) do { _Pragma("unroll") for (int _i = 0; _i < 2; ++_i) \
        __builtin_amdgcn_global_load_lds((const unsigned*)((const char*)(gbase) + (voff)[_i]), (PG8_LAS unsigned*)(lds + (bufoff) + ldsw + _i * 8192), 16, 0, 0); } while (0)
#define PG8_LDA(dst, b, h) do { _Pragma("unroll") for (int m = 0; m < 4; ++m) _Pragma("unroll") for (int k = 0; k < 2; ++k) dst[m][k] = *(const PG8_LAS bf16x8*)(lds + PG8_SA(b, h) + aoff + m * 2048 + k * 1024); } while (0)
#define PG8_LDB(dst, b, h) do { _Pragma("unroll") for (int n = 0; n < 2; ++n) _Pragma("unroll") for (int k = 0; k < 2; ++k) dst[n][k] = *(const PG8_LAS bf16x8*)(lds + PG8_SB(b, h) + boff + n * 2048 + k * 1024); } while (0)
#define PG8_MMA(ai, bj, At, Bt) do { __builtin_amdgcn_s_setprio(1); _Pragma("unroll") for (int m = 0; m < 4; ++m) _Pragma("unroll") for (int n = 0; n < 2; ++n) _Pragma("unroll") for (int k = 0; k < 2; ++k) \
        acc[ai][bj][m][n] = __builtin_amdgcn_mfma_f32_16x16x32_bf16(Bt[n][k], At[m][k], acc[ai][bj][m][n], 0, 0, 0); __builtin_amdgcn_s_setprio(0); } while (0)
#define PG8_WAIT_V(n) asm volatile("s_waitcnt vmcnt(" #n ")" ::: "memory")
#define PG8_WAIT_L(n) asm volatile("s_waitcnt lgkmcnt(" #n ")" ::: "memory")
#define PG8_BAR __builtin_amdgcn_s_barrier()
#define PG8_SCHED __builtin_amdgcn_sched_barrier(0)
    Unit cur, nxt; int ui = 0;
    if (!S.next(0, cur)) return;
    f32x4 acc[2][2][4][2];
#pragma unroll
    for (int a = 0; a < 2; ++a)
#pragma unroll
        for (int b = 0; b < 2; ++b)
#pragma unroll
            for (int m = 0; m < 4; ++m)
#pragma unroll
                for (int n = 0; n < 2; ++n) acc[a][b][m][n] = (f32x4){0.f, 0.f, 0.f, 0.f};
    bf16x8 At[4][2], B0[2][2], B1[2][2];
    const char* cA = (const char*)g.A + (size_t)cur.pm * tstep; const char* cB = (const char*)g.Bt + (size_t)cur.pn * tstep;
    S.a_ready(cur);
    if constexpr (SP2) {
        PG8_STAGE(PG8_SB(0, 0), cB, voffB); PG8_STAGE(PG8_SB(0, 1), cB + hstep, voffB); PG8_STAGE(PG8_SA(0, 0), cA, voffA); PG8_STAGE(PG8_SA(0, 1), cA + hstep, voffA);
        if (wr == 1) PG8_BAR;
        PG8_WAIT_V(2); PG8_BAR;
        PG8_STAGE(PG8_SB(1, 0), cB + kstep, voffB); PG8_STAGE(PG8_SA(1, 0), cA + kstep, voffA); PG8_STAGE(PG8_SB(1, 1), cB + hstep + kstep, voffB);
        PG8_WAIT_V(6); PG8_BAR;
    } else {
        PG8_STAGE(PG8_SB(0, 0), cB, voffB); PG8_STAGE(PG8_SA(0, 0), cA, voffA); PG8_STAGE(PG8_SB(0, 1), cB + hstep, voffB); PG8_STAGE(PG8_SA(0, 1), cA + hstep, voffA);
        if (wr == 1) PG8_BAR;
        PG8_WAIT_V(4); PG8_BAR;
        PG8_STAGE(PG8_SB(1, 0), cB + kstep, voffB); PG8_STAGE(PG8_SA(1, 0), cA + kstep, voffA); PG8_STAGE(PG8_SB(1, 1), cB + hstep + kstep, voffB);
        PG8_WAIT_V(6); PG8_BAR;
    }
    for (;;) {
        const bool has_next = S.next(ui + 1, nxt);
        const char* nA = has_next ? (const char*)g.A + (size_t)nxt.pm * tstep : cA; const char* nB = has_next ? (const char*)g.Bt + (size_t)nxt.pn * tstep : cB;
        for (int t = 0; t < nt; t += 2) {
            const bool last = (t == nt - 2);
            const char* a1 = cA + (size_t)(t + 1) * kstep;
            const char* a2 = last ? nA : cA + (size_t)(t + 2) * kstep; const char* b2 = last ? nB : cB + (size_t)(t + 2) * kstep;
            const char* a3 = a2 + kstep; const char* b3 = b2 + kstep;
            if (last && has_next) S.a_ready(nxt);
            if constexpr (SP2) {
            PG8_LDB(B0, 0, 0); PG8_LDB(B1, 0, 1); PG8_SCHED; PG8_LDA(At, 0, 0); PG8_STAGE(PG8_SA(1, 1), a1 + hstep, voffA);
            PG8_WAIT_V(8); PG8_WAIT_L(0); PG8_BAR; PG8_MMA(0, 0, At, B0); PG8_MMA(0, 1, At, B1); PG8_BAR; PG8_SCHED;
            PG8_LDA(At, 0, 1); PG8_STAGE(PG8_SB(0, 0), b2, voffB); PG8_STAGE(PG8_SB(0, 1), b2 + hstep, voffB); PG8_STAGE(PG8_SA(0, 0), a2, voffA);
            PG8_WAIT_V(8); PG8_WAIT_L(0); PG8_BAR; PG8_MMA(1, 0, At, B0); PG8_MMA(1, 1, At, B1); PG8_BAR; PG8_SCHED;
            PG8_LDB(B0, 1, 0); PG8_LDB(B1, 1, 1); PG8_SCHED; PG8_LDA(At, 1, 0); PG8_STAGE(PG8_SA(0, 1), a2 + hstep, voffA);
            PG8_WAIT_V(8); PG8_WAIT_L(0); PG8_BAR; PG8_MMA(0, 0, At, B0); PG8_MMA(0, 1, At, B1); PG8_BAR; PG8_SCHED;
            PG8_LDA(At, 1, 1); PG8_STAGE(PG8_SB(1, 0), b3, voffB); PG8_STAGE(PG8_SB(1, 1), b3 + hstep, voffB); PG8_STAGE(PG8_SA(1, 0), a3, voffA);
            PG8_WAIT_V(8); PG8_WAIT_L(0); PG8_BAR; PG8_MMA(1, 0, At, B0); PG8_MMA(1, 1, At, B1); PG8_BAR; PG8_SCHED;
            } else {
            PG8_LDB(B0, 0, 0); PG8_SCHED; PG8_LDA(At, 0, 0); PG8_STAGE(PG8_SA(1, 1), a1 + hstep, voffA);
            PG8_WAIT_L(8); PG8_BAR; PG8_WAIT_L(0); PG8_MMA(0, 0, At, B0); PG8_BAR; PG8_SCHED;
            PG8_LDB(B1, 0, 1); PG8_STAGE(PG8_SB(0, 0), b2, voffB);
            PG8_BAR; PG8_WAIT_L(0); PG8_MMA(0, 1, At, B1); PG8_BAR;
            PG8_LDA(At, 0, 1); PG8_STAGE(PG8_SA(0, 0), a2, voffA);
            PG8_BAR; PG8_WAIT_L(0); PG8_MMA(1, 0, At, B0); PG8_BAR; PG8_SCHED;
            PG8_STAGE(PG8_SB(0, 1), b2 + hstep, voffB);
            PG8_WAIT_V(6); PG8_BAR; PG8_MMA(1, 1, At, B1); PG8_BAR;
            PG8_LDB(B0, 1, 0); PG8_SCHED; PG8_LDA(At, 1, 0); PG8_STAGE(PG8_SA(0, 1), a2 + hstep, voffA);
            PG8_WAIT_L(8); PG8_BAR; PG8_WAIT_L(0); PG8_MMA(0, 0, At, B0); PG8_BAR; PG8_SCHED;
            PG8_LDB(B1, 1, 1); PG8_STAGE(PG8_SB(1, 0), b3, voffB);
            PG8_BAR; PG8_WAIT_L(0); PG8_MMA(0, 1, At, B1); PG8_BAR;
            PG8_LDA(At, 1, 1); PG8_STAGE(PG8_SA(1, 0), a3, voffA);
            PG8_BAR; PG8_WAIT_L(0); PG8_MMA(1, 0, At, B0); PG8_BAR; PG8_SCHED;
            PG8_STAGE(PG8_SB(1, 1), b3 + hstep, voffB);
            PG8_WAIT_V(6); PG8_BAR; PG8_MMA(1, 1, At, B1); PG8_BAR;
            }
        }
        if constexpr (ALIGN_EPI) { if (wr == 0) PG8_BAR; }
        if constexpr (!Epi::AFTER_DRAIN) { E(acc, cur, wr, wc, fr, fq); S.done(cur); }
        if (!has_next) break;
#pragma unroll
        for (int a = 0; a < 2; ++a)
#pragma unroll
            for (int b = 0; b < 2; ++b)
#pragma unroll
                for (int m = 0; m < 4; ++m)
#pragma unroll
                    for (int n = 0; n < 2; ++n) acc[a][b][m][n] = (f32x4){0.f, 0.f, 0.f, 0.f};
        cur = nxt; cA = nA; cB = nB; ++ui;
        if constexpr (ALIGN_EPI) { if (wr == 1) PG8_BAR; }
    }
    PG8_WAIT_V(0);
    if constexpr (!ALIGN_EPI) { if (wr == 0) PG8_BAR; }
    PG8_BAR;
    if constexpr (Epi::AFTER_DRAIN) { E.fused(acc, cur, wr, wc, fr, fq, lds, wid, lane); S.done(cur); }
#undef PG8_SA
#undef PG8_SB
#undef PG8_STAGE
#undef PG8_LDA
#undef PG8_LDB
#undef PG8_MMA
#undef PG8_WAIT_V
#undef PG8_WAIT_L
#undef PG8_BAR
#undef PG8_SCHED
}
}
#define LAS __attribute__((address_space(3)))
typedef unsigned short bf16;
typedef float f32x4 __attribute__((ext_vector_type(4)));
typedef short bf16x8 __attribute__((ext_vector_type(8)));
typedef unsigned u32x4 __attribute__((ext_vector_type(4)));
typedef unsigned u32x2 __attribute__((ext_vector_type(2)));
#ifndef MK_MULTI
#define MK_MULTI 0
#endif
constexpr int NTOK = 16384, DM = 1024, SEQ = 2048, DFF = 2816, NA = 2560, NPH = 12;
constexpr int COL_RQ = 0, COL_RK = 512, COL_RG = 1024, COL_SQ = 1536, COL_SK = 2048;
constexpr size_t MiB = 1u << 20;
constexpr size_t WS_BAR = 4096  ;
constexpr size_t WS_CNT = 0, WS_RSS = 65536  , WS_COS = 1 * MiB, WS_SIN = 1 * MiB + 512 * 1024;
constexpr size_t WS_W = 2 * MiB, W_LAYER = 25 * MiB + 512 * 1024, WO_A = 0, WO_V = 5 * MiB, WO_O = 7 * MiB, WO_GU = 9 * MiB, WO_D = 20 * MiB;
constexpr size_t WS_XB = 54 * MiB, WS_MIX = 86 * MiB, WS_PA = 118 * MiB, WS_VT = 198 * MiB, WS_ACT = 118 * MiB, WS_END = 230 * MiB;
constexpr int LDS_BYTES = 147456, LDS_Q = 131072;
constexpr int N_RET = 32 * 4  , N_SBU = 512;

typedef float f32x2_t __attribute__((ext_vector_type(2))); typedef __bf16 bf16x2_t __attribute__((ext_vector_type(2)));
__device__ __forceinline__ unsigned pkbf(float lo, float hi) { f32x2_t v = {lo, hi}; bf16x2_t b = __builtin_convertvector(v, bf16x2_t); return __builtin_bit_cast(unsigned, b); }
__device__ __forceinline__ float bf_lo(unsigned w) { return __uint_as_float(w << 16); }
__device__ __forceinline__ float bf_hi(unsigned w) { return __uint_as_float(w & 0xffff0000u); }
__device__ __forceinline__ float wave_sum(float v) {
#pragma unroll
    for (int o = 1; o < 64; o <<= 1) v += __shfl_xor(v, o);
    return v;
}
#define MFMA16(a, b, c) __builtin_amdgcn_mfma_f32_16x16x32_bf16((a), (b), (c), 0, 0, 0)

struct Args { const float* in[11]; float* out; unsigned char* ws; float inv_freq[64]; float lg2[4]; int ph_lo, ph_hi; };

__device__ __forceinline__ void tr_item(const float* __restrict__ W, int Nsrc, const float* __restrict__ g, int K, bf16* __restrict__ WT, int d0, int k0, int col, float sc, LAS float* scr, int lane) {
    float wv[32];
#pragma unroll
    for (int i = 0; i < 32; ++i) wv[i] = W[(size_t)(k0 + 2 * i + (lane >> 5)) * Nsrc + col];
#pragma unroll
    for (int i = 0; i < 32; ++i) { const int kk = 2 * i + (lane >> 5); const float gv = g ? g[k0 + kk] : 1.0f; scr[kk * 33 + (lane & 31)] = wv[i] * (gv * sc); }
    asm volatile("s_waitcnt lgkmcnt(0)" ::: "memory");
    const int c = lane & 7;
#pragma unroll
    for (int j = 0; j < 4; ++j) { const int n = (lane >> 3) + 8 * j; const LAS float* s = scr + (8 * c) * 33 + n;
        u32x4 o; o.x = pkbf(s[0 * 33], s[1 * 33]); o.y = pkbf(s[2 * 33], s[3 * 33]); o.z = pkbf(s[4 * 33], s[5 * 33]); o.w = pkbf(s[6 * 33], s[7 * 33]);
        *(u32x4*)(WT + (size_t)(d0 + n) * K + k0 + 8 * c) = o; }
    asm volatile("s_waitcnt lgkmcnt(0)" ::: "memory");
}
__device__ __forceinline__ void sincos_acc(float angf, float& s, float& c) {
    const double a = (double)angf, q = rint(a * 0.63661977236758134308), r = a - q * 1.57079632679489661923, r2 = r * r;
    const double sn = r * (1.0 + r2 * (-1.0 / 6 + r2 * (1.0 / 120 + r2 * (-1.0 / 5040 + r2 * (1.0 / 362880 + r2 * (-1.0 / 39916800))))));
    const double cs = 1.0 + r2 * (-0.5 + r2 * (1.0 / 24 + r2 * (-1.0 / 720 + r2 * (1.0 / 40320 + r2 * (-1.0 / 3628800 + r2 * (1.0 / 479001600))))));
    const int n = ((int)q) & 3;
    const double so = (n == 0) ? sn : (n == 1) ? cs : (n == 2) ? -sn : -cs;
    const double co = (n == 0) ? cs : (n == 1) ? -sn : (n == 2) ? -cs : sn;
    s = (float)so; c = (float)co;
}
constexpr int I_A = 16 * 80, I_V = 16 * 32, I_O = 16 * 32, I_GU = 16 * 176, I_D = 44 * 32, I_L = I_A + I_V + I_O + I_GU + I_D;
constexpr int CVT_EARLY = I_A + I_V;
constexpr int N_CVT = (2 * I_L - CVT_EARLY) / 8;
static_assert((I_L - CVT_EARLY) % 8 == 0 && I_L % 8 == 0, "conversion items per block");
__device__ __forceinline__ void cvt_item(const Args& a, LAS float* scr, int it, int lane) {
    unsigned char* ws = a.ws;
    const int l = it / I_L; int r = it % I_L;
    unsigned char* wl = ws + WS_W + (size_t)l * W_LAYER;
    const float* w_in = a.in[2] + (size_t)l * 1024 * 3584; const float* g1 = a.in[1] + l * 1024; const float* g2 = a.in[6] + l * 1024;
    if (r < I_A) { const int db = r % 80, kb = r / 80, dr = 32 * db + (lane & 31), sec = dr >> 9, within = dr & 511; int col; float sc = 1.0f;
        if (sec < 2) { const int h = within >> 7, p = within & 127; col = sec * 512 + h * 128 + (p >> 1) + 64 * (p & 1); if (sec == 1) sc = 0.08838834764831845f; }
        else if (sec == 2) col = 1536 + within;
        else if (sec == 3) { col = 2048 + within; sc = 0.08838834764831845f * 1.4426950408889634f; }
        else col = 2560 + within;
        tr_item(w_in, 3584, g1, 1024, (bf16*)(wl + WO_A), 32 * db, 64 * kb, col, sc, scr, lane); return; } r -= I_A;
    if (r < I_V) { const int db = r % 32, kb = r / 32, dr = 32 * db + (lane & 31); const int col = dr < 512 ? 1024 + dr : 3072 + (dr - 512);
        tr_item(w_in, 3584, g1, 1024, (bf16*)(wl + WO_V), 32 * db, 64 * kb, col, 1.0f, scr, lane); return; } r -= I_V;
    if (r < I_O) { const int db = r % 32, kb = r / 32;
        tr_item(a.in[5] + (size_t)l * 1024 * 1024, 1024, nullptr, 1024, (bf16*)(wl + WO_O), 32 * db, 64 * kb, 32 * db + (lane & 31), 1.0f, scr, lane); return; } r -= I_O;
    if (r < I_GU) { const int db = r % 176, kb = r / 176, d0 = 32 * db, pn = d0 >> 8, j0 = d0 & 255; const bool up = j0 >= 128;
        const float* W = (up ? a.in[8] : a.in[7]) + (size_t)l * 1024 * DFF; const int col = 128 * pn + (j0 & 127) + (lane & 31);
        tr_item(W, DFF, g2, 1024, (bf16*)(wl + WO_GU), d0, 64 * kb, col, 1.0f, scr, lane); return; } r -= I_GU;
    { const int db = r % 32, kb = r / 32;
        tr_item(a.in[9] + (size_t)l * DFF * 1024, 1024, nullptr, DFF, (bf16*)(wl + WO_D), 32 * db, 64 * kb, 32 * db + (lane & 31), 1.0f, scr, lane); }
}
__device__ __forceinline__ void prologue(const Args& a, LAS unsigned char* lds, int G, int tid, int wave, int lane) {
    unsigned char* ws = a.ws;
    const int gw = blockIdx.x * 8 + wave, NGW = G * 8, gt = blockIdx.x * 512 + tid, NGT = G * 512;
    for (int i = gt; i < 4 * NTOK; i += NGT) ((float*)(ws + WS_RSS))[NTOK + i] = 0.f;
    LAS float* ifr = (LAS float*)(lds + LDS_Q + 64);
    if (tid == 0) {
#pragma unroll
        for (int i = 0; i < 64; ++i) ifr[i] = a.inv_freq[i];
    }
    __syncthreads();
    for (int i = gt; i < SEQ * 64; i += NGT) { const int pos = i >> 6, k = i & 63; float s, c; sincos_acc((float)pos * ifr[k], s, c); ((float*)(ws + WS_COS))[i] = c; ((float*)(ws + WS_SIN))[i] = s; }
    LAS float* scr = (LAS float*)(lds + wave * 16384);
    for (int it = gw; it < CVT_EARLY; it += NGW) cvt_item(a, scr, it, lane);
    const float* x = a.in[0]; bf16* xb = (bf16*)(ws + WS_XB); float* rss0 = (float*)(ws + WS_RSS);
    for (int m = gw; m < NTOK; m += 2 * NGW) {
        const int m2 = m + NGW;
        const f32x4* xr = (const f32x4*)(x + (size_t)m * DM) + lane; const f32x4* xr2 = (const f32x4*)(x + (size_t)m2 * DM) + lane; f32x4 v[4], v2[4]; float s = 0.f, s2 = 0.f;
#pragma unroll
        for (int j = 0; j < 4; ++j) { v[j] = xr[64 * j]; v2[j] = xr2[64 * j]; }
#pragma unroll
        for (int j = 0; j < 4; ++j) { s += (v[j][0] * v[j][0] + v[j][1] * v[j][1]) + (v[j][2] * v[j][2] + v[j][3] * v[j][3]); s2 += (v2[j][0] * v2[j][0] + v2[j][1] * v2[j][1]) + (v2[j][2] * v2[j][2] + v2[j][3] * v2[j][3]); }
        s = wave_sum(s); s2 = wave_sum(s2); if (lane == 0) { rss0[m] = s; rss0[m2] = s2; }
        u32x2* o8 = (u32x2*)(xb + (size_t)m * DM) + lane; u32x2* o82 = (u32x2*)(xb + (size_t)m2 * DM) + lane;
#pragma unroll
        for (int j = 0; j < 4; ++j) { u32x2 w; w.x = pkbf(v[j][0], v[j][1]); w.y = pkbf(v[j][2], v[j][3]); o8[64 * j] = w; u32x2 w2; w2.x = pkbf(v2[j][0], v2[j][1]); w2.y = pkbf(v2[j][2], v2[j][3]); o82[64 * j] = w2; }
    }
}
__device__ __forceinline__ void final_norm(const Args& a, int G, int wave, int lane) {
    const int gw = blockIdx.x * 8 + wave, NGW = G * 8; const float* rss = (const float*)(a.ws + WS_RSS) + 4 * NTOK; const float* fg = a.in[10]; const bf16* xb = (const bf16*)(a.ws + WS_XB);
    f32x4 gv[4];
#pragma unroll
    for (int j = 0; j < 4; ++j) gv[j] = ((const f32x4*)fg)[lane + 64 * j];
    for (int m = gw; m < NTOK; m += NGW) {
        const float rstd = 1.0f / sqrtf(rss[m] * (1.0f / 1024.0f) + 1e-6f);
        const u32x2* xr = (const u32x2*)(xb + (size_t)m * DM) + lane; f32x4* orow = (f32x4*)(a.out + (size_t)m * DM) + lane;
#pragma unroll
        for (int j = 0; j < 4; ++j) { const u32x2 w = xr[64 * j]; const f32x4 v = (f32x4){bf_lo(w.x), bf_hi(w.x), bf_lo(w.y), bf_hi(w.y)}; orow[64 * j] = v * rstd * gv[j]; }
    }
}
#define XB_TMO      128
#define XB_XCNT(j)  (256  + 64 * (j))
#define XB_XSUB(j)  (1280 + 64 * (j))
#define XB_XGEN(j)  (2304 + 64 * (j))
#define XB_TOP      3328
#define XB_TOPGEN   3392
#define XCD_BAR_WORDS 3456
#define XB_SPIN_CAP (1u << 18)

__device__ __forceinline__ unsigned xb_ld(unsigned* p)              { return __hip_atomic_load(p, __ATOMIC_RELAXED, __HIP_MEMORY_SCOPE_AGENT); }
__device__ __forceinline__ unsigned xb_add(unsigned* p, unsigned v) { return __hip_atomic_fetch_add(p, v, __ATOMIC_RELAXED, __HIP_MEMORY_SCOPE_AGENT); }
__device__ __forceinline__ unsigned xb_xcc_id() { return (unsigned)__builtin_amdgcn_s_getreg((3 << 11) | 20) & 0xFu; }
#define XB_SPIN(cond, bar) do { unsigned _sp = 0; while (cond) { __builtin_amdgcn_s_sleep(1); \
    if ((++_sp & 255u) == 0u) { if (xb_ld(&(bar)[XB_TMO])) break; if (_sp > XB_SPIN_CAP) { atomicAdd(&(bar)[XB_TMO], 1u); break; } } } } while (0)

struct XcdBarrier {
    unsigned* bar; unsigned x;
    volatile LAS unsigned* st;
};

__device__ __forceinline__ XcdBarrier xcd_barrier_post(unsigned* bar, volatile LAS unsigned* st) {
    XcdBarrier b; b.bar = bar; b.x = xb_xcc_id(); b.st = st;
    if (threadIdx.x == 0) (void)xb_add(&bar[XB_XCNT(b.x)], 1u);
    return b;
}
__device__ __forceinline__ void xcd_barrier_complete(unsigned* bar, unsigned x, unsigned& nloc, unsigned& nx) {
    const unsigned G = gridDim.x * gridDim.y * gridDim.z;
    unsigned sum, cnt, mine, sp = 0u;
    for (;;) {
        sum = 0u; cnt = 0u; mine = 0u;
#pragma unroll
        for (unsigned j = 0; j < 16; ++j) { const unsigned c = xb_ld(&bar[XB_XCNT(j)]); sum += c; cnt += (c > 0u) ? 1u : 0u; mine = (j == x) ? c : mine; }
        if (sum == G) break;
        __builtin_amdgcn_s_sleep(1);
        if ((++sp & 255u) == 0u) { if (xb_ld(&bar[XB_TMO])) break; if (sp > XB_SPIN_CAP) { atomicAdd(&bar[XB_TMO], 1u); break; } }
    }
    nloc = mine > 0u ? mine : 1u; nx = cnt > 0u ? cnt : 1u;
}

__device__ __forceinline__ void xcd_barrier(const XcdBarrier& b) {
    asm volatile("s_waitcnt vmcnt(0)" ::: "memory");
    __syncthreads();
    if (threadIdx.x == 0) {
        unsigned* bar = b.bar;
        __builtin_amdgcn_s_waitcnt(0);
        unsigned nloc = b.st[0], nx = b.st[1];
        if (nloc == 0u) { xcd_barrier_complete(bar, b.x, nloc, nx); b.st[0] = nloc; b.st[1] = nx; }
        const unsigned old = xb_add(&bar[XB_XSUB(b.x)], 1u);
        const unsigned gen = old / nloc;
        if (old + 1u == (gen + 1u) * nloc) {
            __builtin_amdgcn_fence(__ATOMIC_RELEASE, "agent");
            asm volatile("s_waitcnt vmcnt(0)" ::: "memory");
            const unsigned og = xb_add(&bar[XB_TOP], 1u);
            const unsigned tg = og / nx;
            if (og + 1u == (tg + 1u) * nx) xb_add(&bar[XB_TOPGEN], 1u);
            else XB_SPIN(xb_ld(&bar[XB_TOPGEN]) == tg, bar);
            __builtin_amdgcn_fence(__ATOMIC_ACQUIRE, "agent");
            xb_add(&bar[XB_XGEN(b.x)], 1u);
            asm volatile("s_waitcnt vmcnt(0)" ::: "memory");
        } else {
            XB_SPIN(xb_ld(&bar[XB_XGEN(b.x)]) == gen, bar);
            __builtin_amdgcn_fence(__ATOMIC_ACQUIRE, "agent");
            asm volatile("s_waitcnt vmcnt(0)" ::: "memory");
        }
    }
    __syncthreads();
}
constexpr int RET_P = 4, RET_CPP = 32 / RET_P;
constexpr int R_QS = 0, R_KS = 17408, R_KT = 34816, R_VT = 53248, R_SD = 71680, R_ST = 80896, R_OF = 0;
__device__ __forceinline__ void ret_item(LAS unsigned char* lds, const bf16* __restrict__ PA, const bf16* __restrict__ VT, bf16* __restrict__ MIX, const float* __restrict__ gret, float lg2, int b, int h, int part_p, int tid, int wid, int lane) {
    const int fr = lane & 15, fq = lane >> 4;
    f32x4 st[8];
#pragma unroll
    for (int i = 0; i < 8; ++i) st[i] = (f32x4){0.f, 0.f, 0.f, 0.f};
    for (int i = tid; i < 34816 / 16; i += 512) *(LAS u32x4*)(lds + R_ST + i * 16) = (u32x4){0u, 0u, 0u, 0u};
    const float cd = __builtin_amdgcn_exp2f(lg2 * 64.0f);
    const bf16* qg = PA + (size_t)(b * SEQ) * NA + COL_RQ + h * 128;
    const bf16* kg = PA + (size_t)(b * SEQ) * NA + COL_RK + h * 128;
    const bf16* gg = PA + (size_t)(b * SEQ) * NA + COL_RG + h * 128;
    const bf16* vg = VT + (size_t)(h * 128) * NTOK + b * SEQ;
    u32x4 qr[2], kr[2], vr[2], gr[2];
    const int nfull0 = RET_CPP * part_p, nend = nfull0 + RET_CPP;
#define LOAD_KV(KR, VR, n) do { _Pragma("unroll") for (int i = 0; i < 2; ++i) { const int pi = tid + 512 * i; \
        KR[i] = *(const u32x4*)(kg + (size_t)(64 * (n) + (pi >> 4)) * NA + 8 * (pi & 15)); VR[i] = *(const u32x4*)(vg + (size_t)(pi >> 3) * NTOK + 64 * (n) + 8 * (pi & 7)); } } while (0)
#define RET_LOAD(n) do { LOAD_KV(kr, vr, n); _Pragma("unroll") for (int i = 0; i < 2; ++i) { const int pi = tid + 512 * i; qr[i] = *(const u32x4*)(qg + (size_t)(64 * (n) + (pi >> 4)) * NA + 8 * (pi & 15)); } } while (0)
#define STAGE_KV(KR, VR) do { _Pragma("unroll") for (int i = 0; i < 2; ++i) { const int pi = tid + 512 * i, row = pi >> 4, c8 = pi & 15; \
            const float kd = __builtin_amdgcn_exp2f(lg2 * (float)(63 - row)); const int sw = R_KT + (((row >> 3) ^ (c8 & 7)) << 4) + (row & 7) * 2; \
            _Pragma("unroll") for (int j = 0; j < 4; ++j) { const unsigned w = KR[i][j]; const unsigned p = pkbf(bf_lo(w) * kd, bf_hi(w) * kd); \
                *(LAS unsigned short*)(lds + sw + (8 * c8 + 2 * j) * 144) = (unsigned short)(p & 0xffffu); *(LAS unsigned short*)(lds + sw + (8 * c8 + 2 * j + 1) * 144) = (unsigned short)(p >> 16); } \
            *(LAS u32x4*)(lds + R_VT + (pi >> 3) * 144 + (pi & 7) * 16) = VR[i]; } } while (0)
#define STEP4(VA, WRITE_ST) do { _Pragma("unroll") for (int dt = 0; dt < 8; ++dt) { st[dt] = st[dt] * cd; \
            _Pragma("unroll") for (int ks = 0; ks < 2; ++ks) { const int d = 16 * dt + fr; const bf16x8 kb = *(const LAS bf16x8*)(lds + R_KT + d * 144 + (((4 * ks + fq) ^ ((d >> 3) & 7)) << 4)); st[dt] = MFMA16(VA[ks], kb, st[dt]); } \
            if (WRITE_ST) { _Pragma("unroll") for (int r = 0; r < 4; ++r) { const unsigned p = pkbf(st[dt][r], 0.f); *(LAS unsigned short*)(lds + R_ST + (16 * wid + 4 * fq + r) * 272 + (16 * dt + fr) * 2) = (unsigned short)(p & 0xffffu); } } \
            asm volatile("" ::: "memory"); } } while (0)
#define LOAD_VA(VA) do { _Pragma("unroll") for (int ks = 0; ks < 2; ++ks) VA[ks] = *(const LAS bf16x8*)(lds + R_VT + (16 * wid + fr) * 144 + (32 * ks + 8 * fq) * 2); } while (0)
    if (nfull0 > 0) {
        LOAD_KV(kr, vr, 0); LOAD_KV(qr, gr, 1);
        for (int n = 0; n < nfull0; n += 2) {
            __syncthreads(); STAGE_KV(kr, vr); __syncthreads();
            if (n + 2 < nfull0) LOAD_KV(kr, vr, n + 2);
            { bf16x8 vp[2]; LOAD_VA(vp); STEP4(vp, false); }
            __syncthreads(); STAGE_KV(qr, gr); __syncthreads();
            const bool lastp = (n + 2 >= nfull0);
            if (!lastp) LOAD_KV(qr, gr, n + 3); else RET_LOAD(nfull0);
            { bf16x8 vp[2]; LOAD_VA(vp); STEP4(vp, lastp); }
        }
    } else RET_LOAD(0);
    for (int n = nfull0; n < nend; ++n) {
        __syncthreads();
#pragma unroll
        for (int i = 0; i < 2; ++i) { const int pi = tid + 512 * i, row = pi >> 4, c8 = pi & 15;
            *(LAS u32x4*)(lds + R_QS + row * 272 + c8 * 16) = qr[i]; *(LAS u32x4*)(lds + R_KS + row * 272 + c8 * 16) = kr[i]; }
        STAGE_KV(kr, vr);
        __syncthreads();
        if (n + 1 < nend) RET_LOAD(n + 1);
        gr[0] = *(const u32x4*)(gg + (size_t)(64 * n + (tid >> 3)) * NA + 16 * (tid & 7)); gr[1] = *(const u32x4*)(gg + (size_t)(64 * n + (tid >> 3)) * NA + 16 * (tid & 7) + 8);
#pragma unroll
        for (int q = 0; q < 2; ++q) { const int idx = 2 * wid + q, stile = idx >> 2, ttile = idx & 3; f32x4 acc = (f32x4){0.f, 0.f, 0.f, 0.f};
#pragma unroll
            for (int ks = 0; ks < 4; ++ks) { const bf16x8 ka = *(const LAS bf16x8*)(lds + R_KS + (16 * stile + fr) * 272 + (32 * ks + 8 * fq) * 2), qb = *(const LAS bf16x8*)(lds + R_QS + (16 * ttile + fr) * 272 + (32 * ks + 8 * fq) * 2);
                acc = MFMA16(ka, qb, acc); }
            const int t = 16 * ttile + fr, s0 = 16 * stile + 4 * fq; float v[4];
#pragma unroll
            for (int r = 0; r < 4; ++r) { const int d = t - (s0 + r); v[r] = acc[r] * __builtin_amdgcn_exp2f(lg2 * (float)(d < 0 ? -d : d)); }
            u32x2 w; w.x = pkbf(v[0], v[1]); w.y = pkbf(v[2], v[3]); *(LAS u32x2*)(lds + R_SD + t * 144 + s0 * 2) = w; }
        f32x4 cacc[4], iacc[4];
#pragma unroll
        for (int tt = 0; tt < 4; ++tt) { cacc[tt] = (f32x4){0.f, 0.f, 0.f, 0.f}; iacc[tt] = (f32x4){0.f, 0.f, 0.f, 0.f}; }
#pragma unroll
        for (int ks = 0; ks < 4; ++ks) { const bf16x8 sa = *(const LAS bf16x8*)(lds + R_ST + (16 * wid + fr) * 272 + (32 * ks + 8 * fq) * 2);
#pragma unroll
            for (int tt = 0; tt < 4; ++tt) { const bf16x8 qb = *(const LAS bf16x8*)(lds + R_QS + (16 * tt + fr) * 272 + (32 * ks + 8 * fq) * 2); cacc[tt] = MFMA16(sa, qb, cacc[tt]); } asm volatile("" ::: "memory"); }
        __syncthreads();
        bf16x8 va[2];
#pragma unroll
        for (int ks = 0; ks < 2; ++ks) { va[ks] = *(const LAS bf16x8*)(lds + R_VT + (16 * wid + fr) * 144 + (32 * ks + 8 * fq) * 2);
#pragma unroll
            for (int tt = 0; tt < 4; ++tt) { const bf16x8 sb = *(const LAS bf16x8*)(lds + R_SD + (16 * tt + fr) * 144 + (32 * ks + 8 * fq) * 2); iacc[tt] = MFMA16(va[ks], sb, iacc[tt]); } }
        STEP4(va, true);
#pragma unroll
        for (int tt = 0; tt < 4; ++tt) { const int t = 16 * tt + fr; const float qd = __builtin_amdgcn_exp2f(lg2 * (float)(t + 1));
            const f32x4 o = iacc[tt] + cacc[tt] * qd; *(LAS f32x4*)(lds + R_OF + t * 528 + (16 * wid + 4 * fq) * 4) = o; }
        __syncthreads();
        { const int t = tid >> 3, part = tid & 7; const size_t row = (size_t)(b * SEQ + 64 * n + t); f32x4 x[4]; float s = 0.f;
#pragma unroll
            for (int j = 0; j < 4; ++j) { x[j] = *(const LAS f32x4*)(lds + R_OF + t * 528 + (16 * part + 4 * j) * 4); s += (x[j][0] + x[j][1]) + (x[j][2] + x[j][3]); }
            s += __shfl_xor(s, 1); s += __shfl_xor(s, 2); s += __shfl_xor(s, 4);
            const float mu = s * (1.0f / 128.0f); float q = 0.f;
#pragma unroll
            for (int j = 0; j < 4; ++j) { x[j] = x[j] - mu; q += (x[j][0] * x[j][0] + x[j][1] * x[j][1]) + (x[j][2] * x[j][2] + x[j][3] * x[j][3]); }
            q += __shfl_xor(q, 1); q += __shfl_xor(q, 2); q += __shfl_xor(q, 4);
            const float rstd = 1.0f / sqrtf(q * (1.0f / 128.0f) + 1e-6f);
            const u32x4 g0 = gr[0], g1 = gr[1];
            float y[16];
#pragma unroll
            for (int j = 0; j < 4; ++j) { const f32x4 gn = *(const f32x4*)(gret + h * 128 + 16 * part + 4 * j);
#pragma unroll
                for (int c = 0; c < 4; ++c) { const unsigned gw = (j < 2 ? g0 : g1)[(2 * j + (c >> 1)) & 3]; const float gt = (c & 1) ? bf_hi(gw) : bf_lo(gw);
                    y[4 * j + c] = x[j][c] * rstd * gn[c] * (gt * __builtin_amdgcn_rcpf(1.0f + __expf(-gt))); } }
            u32x4 o0, o1; o0.x = pkbf(y[0], y[1]); o0.y = pkbf(y[2], y[3]); o0.z = pkbf(y[4], y[5]); o0.w = pkbf(y[6], y[7]); o1.x = pkbf(y[8], y[9]); o1.y = pkbf(y[10], y[11]); o1.z = pkbf(y[12], y[13]); o1.w = pkbf(y[14], y[15]);
            *(u32x4*)(MIX + row * DM + h * 128 + 16 * part) = o0; *(u32x4*)(MIX + row * DM + h * 128 + 16 * part + 8) = o1; }
    }
#undef RET_LOAD
#undef LOAD_KV
#undef STAGE_KV
#undef STEP4
#undef LOAD_VA
}
constexpr int S_KS = 0, S_VT = 17408;
__device__ __forceinline__ void sb_unit(LAS unsigned char* lds, const bf16* __restrict__ PA, const bf16* __restrict__ VT, bf16* __restrict__ MIX, const float* __restrict__ gsb, int b, int h, int qb, int tid, int wid, int lane) {
    const int fr = lane & 15, fq = lane >> 4, t0 = qb * 128 + wid * 16, tq = t0 + fr;
    const size_t rowq = (size_t)(b * SEQ + tq);
    bf16x8 qf[4];
#pragma unroll
    for (int ks = 0; ks < 4; ++ks) qf[ks] = *(const bf16x8*)(PA + rowq * NA + COL_SQ + h * 128 + 32 * ks + 8 * fq);
    f32x4 o[8];
#pragma unroll
    for (int i = 0; i < 8; ++i) o[i] = (f32x4){0.f, 0.f, 0.f, 0.f};
    float carry = 0.f;
    const bf16* kg = PA + (size_t)(b * SEQ) * NA + COL_SK + h * 128;
    const bf16* vg = VT + (size_t)(512 + h * 128) * NTOK + b * SEQ;
    u32x4 kr[2], vr[2];
#define SB_LOAD(kb) do { _Pragma("unroll") for (int i = 0; i < 2; ++i) { const int pi = tid + 512 * i; \
        kr[i] = *(const u32x4*)(kg + (size_t)(64 * (kb) + (pi >> 4)) * NA + 8 * (pi & 15)); vr[i] = *(const u32x4*)(vg + (size_t)(pi >> 3) * NTOK + 64 * (kb) + 8 * (pi & 7)); } } while (0)
    const int nkb = 2 * qb + 2;
    SB_LOAD(nkb - 1);
    volatile LAS unsigned* sflag = (volatile LAS unsigned*)(lds + LDS_Q + 1024);
    if (lane == 0) sflag[wid] = 0u;
    for (int kb = nkb - 1; kb >= 0; --kb) {
        __syncthreads();
        { unsigned all = 1u;
#pragma unroll
          for (int w8 = 0; w8 < 8; ++w8) all &= sflag[w8];
          if (__builtin_amdgcn_readfirstlane(all)) break; }
#pragma unroll
        for (int i = 0; i < 2; ++i) { const int pi = tid + 512 * i; *(LAS u32x4*)(lds + S_KS + (pi >> 4) * 272 + (pi & 15) * 16) = kr[i]; *(LAS u32x4*)(lds + S_VT + (pi >> 3) * 144 + (pi & 7) * 16) = vr[i]; }
        __syncthreads();
        if (kb > 0) SB_LOAD(kb - 1);
        if (64 * kb < t0 + 15) {
            f32x4 s[4];
#pragma unroll
            for (int kt = 0; kt < 4; ++kt) { s[kt] = (f32x4){0.f, 0.f, 0.f, 0.f}; const int krow = 32 * (kt >> 1) + 8 * (fr >> 2) + 4 * (kt & 1) + (fr & 3);
#pragma unroll
                for (int ks = 0; ks < 4; ++ks) { const bf16x8 ka = *(const LAS bf16x8*)(lds + S_KS + krow * 272 + (32 * ks + 8 * fq) * 2); s[kt] = MFMA16(ka, qf[ks], s[kt]); } }
            bf16x8 wf[2];
#pragma unroll
            for (int p = 1; p >= 0; --p) {
                const int key0 = 64 * kb + 32 * p + 8 * fq; float m[8], lk[8], ex[8];
#pragma unroll
                for (int j = 0; j < 8; ++j) { const float z = s[2 * p + (j >> 2)][j & 3]; const float e = __builtin_amdgcn_exp2f(-fabsf(z)); const float lg = __builtin_amdgcn_logf(1.0f + e);
                    m[j] = fminf(z, 0.f) - lg; lk[j] = (key0 + j < tq) ? (m[j] - z) : 0.f; }
                ex[7] = 0.f;
#pragma unroll
                for (int j = 6; j >= 0; --j) ex[j] = ex[j + 1] + lk[j + 1];
                const float G = ex[0] + lk[0], G1 = __shfl_xor(G, 16), G2 = __shfl_xor(G, 32), G3 = __shfl_xor(G, 48);
                const float off = (((fq ^ 1) > fq) ? G1 : 0.f) + (((fq ^ 2) > fq) ? G2 : 0.f) + (((fq ^ 3) > fq) ? G3 : 0.f);
                const float base = carry + off; float w[8];
#pragma unroll
                for (int j = 0; j < 8; ++j) w[j] = (key0 + j < tq) ? __builtin_amdgcn_exp2f(m[j] + base + ex[j]) : 0.f;
                carry += (G + G1) + (G2 + G3);
                u32x4 pw; pw.x = pkbf(w[0], w[1]); pw.y = pkbf(w[2], w[3]); pw.z = pkbf(w[4], w[5]); pw.w = pkbf(w[6], w[7]);
                wf[p] = __builtin_bit_cast(bf16x8, pw);
            }
#pragma unroll
            for (int et = 0; et < 8; ++et)
#pragma unroll
                for (int p = 0; p < 2; ++p) { const bf16x8 va = *(const LAS bf16x8*)(lds + S_VT + (16 * et + fr) * 144 + (32 * p + 8 * fq) * 2); o[et] = MFMA16(va, wf[p], o[et]); }
            const bool dn = __all(carry < -150.0f);
            if (lane == 0) sflag[wid] = dn ? 1u : 0u;
        }
    }
#undef SB_LOAD
    float ss = 0.f;
#pragma unroll
    for (int et = 0; et < 8; ++et) ss += (o[et][0] * o[et][0] + o[et][1] * o[et][1]) + (o[et][2] * o[et][2] + o[et][3] * o[et][3]);
    ss += __shfl_xor(ss, 16); ss += __shfl_xor(ss, 32);
    const float rstd = 1.0f / sqrtf(ss * (1.0f / 128.0f) + 1e-6f);
#pragma unroll
    for (int et = 0; et < 8; ++et) { const f32x4 gn = *(const f32x4*)(gsb + h * 128 + 16 * et + 4 * fq); const f32x4 y = o[et] * rstd * gn;
        u32x2 w; w.x = pkbf(y[0], y[1]); w.y = pkbf(y[2], y[3]); *(u32x2*)(MIX + rowq * DM + 512 + h * 128 + 16 * et + 4 * fq) = w; }
}
__device__ __forceinline__ int lane_now() { int x; asm volatile("v_mbcnt_lo_u32_b32 %0, -1, 0\n\tv_mbcnt_hi_u32_b32 %0, -1, %0" : "=v"(x)); return x; }
__global__ void __launch_bounds__(512, 2) hymba_fwd(Args a) {
    extern __shared__ __attribute__((aligned(16))) unsigned char lds_raw[];
    LAS unsigned char* lds = (LAS unsigned char*)lds_raw;
    const int wave_s = __builtin_amdgcn_readfirstlane((int)threadIdx.x >> 6), G = gridDim.x;
#define tid (wave_s * 64 + lane_now())
    unsigned char* ws = a.ws;
    volatile LAS unsigned* xst = (volatile LAS unsigned*)(lds + LDS_Q + 512);
    if (tid < 2) xst[tid] = 0u;
    __syncthreads();
#if !MK_MULTI
    XcdBarrier xbar = xcd_barrier_post((unsigned*)(ws + WS_BAR), xst);
#endif
    const int lo = a.ph_lo, hi = a.ph_hi;
#define OPAQUE_TID() int tp = tid; asm volatile("" : "+v"(tp)); const int lp = tp & 63, wp = __builtin_amdgcn_readfirstlane(tp >> 6); (void)lp; (void)wp
#define IN(k) (lo <= (k) && (k) < hi)
#if MK_MULTI
#define SEAM(k) do { } while (0)
#else
#define SEAM(k) do { if (IN(k) && IN((k) + 1)) { xcd_barrier(xbar); } } while (0)
#endif
    bf16* xb = (bf16*)(ws + WS_XB); bf16* mix = (bf16*)(ws + WS_MIX); bf16* pa = (bf16*)(ws + WS_PA); bf16* vt = (bf16*)(ws + WS_VT); bf16* act = (bf16*)(ws + WS_ACT);
    float* rss = (float*)(ws + WS_RSS); const float* cst = (const float*)(ws + WS_COS); const float* snt = (const float*)(ws + WS_SIN);
#ifndef NO_PRO
#if !MK_MULTI
    if (a.ph_hi < 0) cg::this_grid().sync();
#endif
    if (IN(0)) { OPAQUE_TID(); prologue(a, lds, G, tp, wp, lp); }
#endif
    SEAM(0);
    for (int l = 0; l < 2; ++l) {
        const unsigned char* wl = ws + WS_W + (size_t)l * W_LAYER; const int p0 = 1 + 5 * l;
#ifndef NO_A
        if (IN(p0)) {
            { OPAQUE_TID(); pg8::Gemm g{xb, (const bf16*)(wl + WO_A), NTOK, NA, DM}; pg8::StaticOrder S; S.init(NTOK, NA, G, (int)blockIdx.x);
              pg8::EpiA E{pa, rss + (2 * l) * NTOK, cst, snt}; pg8::gemm_phase<pg8::EpiA, pg8::StaticOrder, true, true>(lds, g, S, E, tp); }
            { OPAQUE_TID(); pg8::Gemm g{(const bf16*)(wl + WO_V), xb, 1024, NTOK, DM}; pg8::StaticOrder S; S.init(1024, NTOK, G, (int)blockIdx.x);
              pg8::EpiVT E{vt, rss + (2 * l) * NTOK}; pg8::gemm_phase<pg8::EpiVT, pg8::StaticOrder, true, true>(lds, g, S, E, tp); }
            if (l == 0 && G == 256 && blockIdx.x >= 128) {
                OPAQUE_TID();
                for (int j = (int)blockIdx.x - 128; j < (I_L - CVT_EARLY) / 8; j += 128) cvt_item(a, (LAS float*)(lds + wp * 16384), CVT_EARLY + j * 8 + wp, lp);
            } else if (l == 0 && G != 256) { OPAQUE_TID(); for (int j = (int)blockIdx.x; j < (I_L - CVT_EARLY) / 8; j += G) cvt_item(a, (LAS float*)(lds + wp * 16384), CVT_EARLY + j * 8 + wp, lp); }
        }
#endif
        SEAM(p0);
#ifndef NO_B
        if (IN(p0 + 1)) {
            OPAQUE_TID(); unsigned* cnt = (unsigned*)(ws + WS_CNT) + l; LAS int* qs = (LAS int*)(lds + LDS_Q);
            const float* gret = a.in[3] + l * 512; const float* gsb = a.in[4] + l * 512;
            for (;;) {
                __syncthreads();
                if (tp == 0) *qs = (int)atomicAdd(cnt, 1u);
                __syncthreads();
                const int item = __builtin_amdgcn_readfirstlane(*qs);
                int ti = tp; asm volatile("" : "+v"(ti)); const int li = ti & 63, wi = __builtin_amdgcn_readfirstlane(ti >> 6);
                if (item >= N_RET + N_SBU) break;
#ifdef NO_RET
                if (item < N_RET) {}
#else
                if (item < N_RET) { const int bh = item & 31, pp = RET_P - 1 - (item >> 5); ret_item(lds, pa, vt, mix, gret, ((bh & 3) == 0 ? a.lg2[0] : (bh & 3) == 1 ? a.lg2[1] : (bh & 3) == 2 ? a.lg2[2] : a.lg2[3]), bh >> 2, bh & 3, pp, ti, wi, li); }
#endif
#ifdef NO_SBU
                else {}
#else
                else { const int idx = item - N_RET, qb = 15 - (idx >> 5), bh = idx & 31; sb_unit(lds, pa, vt, mix, gsb, bh >> 2, bh & 3, qb, ti, wi, li); }
#endif
            }
        }
#endif
        SEAM(p0 + 1);
#ifndef NO_C
        if (IN(p0 + 2)) {
            OPAQUE_TID(); pg8::Gemm g{mix, (const bf16*)(wl + WO_O), NTOK, DM, DM}; pg8::StaticOrder S; S.init(NTOK, DM, G, (int)blockIdx.x);
            if (l == 0) { pg8::EpiResid<true> E{a.in[0], xb, rss + (2 * l + 1) * NTOK}; pg8::gemm_phase<pg8::EpiResid<true>, pg8::StaticOrder, true, true>(lds, g, S, E, tp); }
            else { pg8::EpiResid<false> E{nullptr, xb, rss + (2 * l + 1) * NTOK}; pg8::gemm_phase<pg8::EpiResid<false>, pg8::StaticOrder, true, true>(lds, g, S, E, tp); }
        }
#endif
        SEAM(p0 + 2);
#ifndef NO_D
        if (IN(p0 + 3)) {
            OPAQUE_TID(); pg8::Gemm g{xb, (const bf16*)(wl + WO_GU), NTOK, 2 * DFF, DM}; pg8::StaticOrder S; S.init(NTOK, 2 * DFF, G, (int)blockIdx.x);
            pg8::EpiSwiGLU E{act, rss + (2 * l + 1) * NTOK}; pg8::gemm_phase<pg8::EpiSwiGLU, pg8::StaticOrder, true, true>(lds, g, S, E, tp);
            if (l == 0 && G == 256 && blockIdx.x >= 128) {
                int t3 = tid; asm volatile("" : "+v"(t3)); const int l3 = t3 & 63, w3 = __builtin_amdgcn_readfirstlane(t3 >> 6);
                for (int j = (int)blockIdx.x - 128; j < I_L / 8; j += 128) cvt_item(a, (LAS float*)(lds + w3 * 16384), I_L + j * 8 + w3, l3);
            } else if (l == 0 && G != 256) { int t3 = tid; asm volatile("" : "+v"(t3)); const int l3 = t3 & 63, w3 = __builtin_amdgcn_readfirstlane(t3 >> 6); for (int j = (int)blockIdx.x; j < I_L / 8; j += G) cvt_item(a, (LAS float*)(lds + w3 * 16384), I_L + j * 8 + w3, l3); }
        }
#endif
        SEAM(p0 + 3);
#ifndef NO_E
        if (IN(p0 + 4)) {
            OPAQUE_TID(); pg8::Gemm g{act, (const bf16*)(wl + WO_D), NTOK, DM, DFF}; pg8::StaticOrder S; S.init(NTOK, DM, G, (int)blockIdx.x);
            pg8::EpiResid<false> E{nullptr, xb, rss + (2 * l + 2) * NTOK}; pg8::gemm_phase<pg8::EpiResid<false>, pg8::StaticOrder, true, true>(lds, g, S, E, tp);
        }
#endif
        SEAM(p0 + 4);
    }
    if (IN(11)) { OPAQUE_TID(); final_norm(a, G, wp, lp); }
#undef IN
#undef SEAM
#undef tid
}
extern "C" void kernel_launch(void* const* d_in, const int* in_sizes, int n_in, void* d_out, int out_size, void* d_ws, size_t ws_size, hipStream_t stream) {
    static int grid = 0;
    if (grid == 0) {
        if (n_in != 11 || in_sizes[0] != NTOK * DM || out_size != NTOK * DM || ws_size < WS_END) { fprintf(stderr, "kernel_launch: unexpected shapes (n_in %d, ws %zu)\n", n_in, ws_size); grid = -1; return; }
        int dev = 0, cus = 0, per_cu = 0;
        if (hipGetDevice(&dev) != hipSuccess || hipDeviceGetAttribute(&cus, hipDeviceAttributeMultiprocessorCount, dev) != hipSuccess) { grid = -1; return; }
        if (hipFuncSetAttribute((const void*)hymba_fwd, hipFuncAttributeMaxDynamicSharedMemorySize, LDS_BYTES) != hipSuccess) { fprintf(stderr, "kernel_launch: hipFuncSetAttribute failed\n"); grid = -1; return; }
        if (hipOccupancyMaxActiveBlocksPerMultiprocessor(&per_cu, (const void*)hymba_fwd, 512, LDS_BYTES) != hipSuccess || per_cu < 1) { fprintf(stderr, "kernel_launch: occupancy query says %d\n", per_cu); per_cu = 1; }
        (void)hipGetLastError();
        grid = cus;
        if (grid > 256) grid = 256;
    }
    if (grid < 0) return;
    (void)hipMemsetAsync(d_ws, 0, 65536, stream);
    Args a{};
    for (int i = 0; i < 11; ++i) a.in[i] = (const float*)d_in[i];
    a.out = (float*)d_out; a.ws = (unsigned char*)d_ws;
    for (int i = 0; i < 64; ++i) a.inv_freq[i] = 1.0f / powf(10000.0f, (float)(2 * i) / 128.0f);
    for (int h = 0; h < 4; ++h) a.lg2[h] = (float)(log1p(-exp2(-5.0 - (double)h)) / log(2.0));
#if MK_MULTI
    for (int p = 0; p < NPH; ++p) { a.ph_lo = p; a.ph_hi = p + 1; hipLaunchKernelGGL(hymba_fwd, dim3(grid), dim3(512), LDS_BYTES, stream, a); }
#else
    a.ph_lo = 0; a.ph_hi = NPH;
    void* args[] = {&a};
    hipError_t e = hipLaunchCooperativeKernel((const void*)hymba_fwd, dim3(grid), dim3(512), args, LDS_BYTES, stream);
    if (e != hipSuccess) fprintf(stderr, "cooperative launch failed: %s (grid %d)\n", hipGetErrorString(e), grid);
#endif
}
```
